# Optimizing an MI355X kernel written in HIP

```python
import jax, jax.numpy as jnp
from jax import lax
import numpy as np

D_MODEL = 1024
BATCH = 16
SEQ = 2048
DEPTH = 4

N_MIXERS = 2
N_CONV_LAYERS = (DEPTH + 1) // 2
N_MLA_LAYERS = DEPTH // 2
N_DENSE_LAYERS = (DEPTH + 1) // 2
N_MOE_LAYERS = DEPTH // 2
CONV_WIDTH = 3
N_HEADS = 8
QK_NOPE_DIM = 128
QK_ROPE_DIM = 64
QK_HEAD_DIM = QK_NOPE_DIM + QK_ROPE_DIM
V_HEAD_DIM = 128
Q_LORA_RANK = 384
KV_LORA_RANK = 256
ROPE_THETA = 10000.0
Q_BLOCK = 128
D_FF_DENSE = 2816
N_EXPERTS = 8
TOP_K = 2
D_FF_EXPERT = 2048
EPS = 1e-6

kernel_name = "hybrid_shortconv_mla_moe_trunk"


def rmsnorm(x, g):
    xf = x.astype(jnp.float32)
    y = xf * lax.rsqrt(jnp.mean(xf * xf, axis=-1, keepdims=True) + EPS)
    return (y * g.astype(jnp.float32)).astype(x.dtype)


def rope_tables(positions):
    inv_freq = ROPE_THETA ** (-jnp.arange(0, QK_ROPE_DIM, 2, dtype=jnp.float32) / QK_ROPE_DIM)
    ang = positions.astype(jnp.float32)[..., None] * inv_freq
    return jnp.cos(ang)[:, :, None, :], jnp.sin(ang)[:, :, None, :]


def apply_rope(x, cos, sin):
    x1, x2 = jnp.split(x, 2, axis=-1)
    cos = cos.astype(x.dtype)
    sin = sin.astype(x.dtype)
    return jnp.concatenate([x1 * cos - x2 * sin, x2 * cos + x1 * sin], axis=-1)


def short_conv_mixer(h, w_in, w_conv, w_out):
    seq = h.shape[1]
    b_gate, c_gate, u = jnp.split(h @ w_in, 3, axis=-1)
    v = c_gate * u
    vp = jnp.pad(v, ((0, 0), (CONV_WIDTH - 1, 0), (0, 0)))
    conv = vp[:, 0:seq] * w_conv[0]
    for k in range(1, CONV_WIDTH):
        conv = conv + vp[:, k:k + seq] * w_conv[k]
    return (b_gate * conv) @ w_out


def mla_mixer(h, cos, sin, w_down, q_a_norm, kv_a_norm, w_uq, w_ukv, q_norm, k_norm, w_o):
    bsz, seq, _ = h.shape
    down = h @ w_down
    c_q = rmsnorm(down[..., :Q_LORA_RANK], q_a_norm)
    c_kv = rmsnorm(down[..., Q_LORA_RANK:Q_LORA_RANK + KV_LORA_RANK], kv_a_norm)
    k_rope = down[..., Q_LORA_RANK + KV_LORA_RANK:]
    q = (c_q @ w_uq).reshape(bsz, seq, N_HEADS, QK_HEAD_DIM)
    kv = (c_kv @ w_ukv).reshape(bsz, seq, N_HEADS, QK_NOPE_DIM + V_HEAD_DIM)
    k_nope, v = kv[..., :QK_NOPE_DIM], kv[..., QK_NOPE_DIM:]
    k_rope_h = jnp.broadcast_to(k_rope[:, :, None, :], (bsz, seq, N_HEADS, QK_ROPE_DIM))
    k = jnp.concatenate([k_nope, k_rope_h], axis=-1)
    q = rmsnorm(q, q_norm)
    k = rmsnorm(k, k_norm)
    q = jnp.concatenate([q[..., :QK_NOPE_DIM], apply_rope(q[..., QK_NOPE_DIM:], cos, sin)], axis=-1)
    k = jnp.concatenate([k[..., :QK_NOPE_DIM], apply_rope(k[..., QK_NOPE_DIM:], cos, sin)], axis=-1)
    scale = QK_HEAD_DIM ** -0.5
    neg = jnp.finfo(jnp.float32).min
    outs = []
    for blk in range(seq // Q_BLOCK):
        s0 = blk * Q_BLOCK
        end = s0 + Q_BLOCK
        scores = jnp.einsum('bqhd,bkhd->bhqk', q[:, s0:end], k[:, :end]).astype(jnp.float32) * scale
        mask = jnp.arange(end)[None, :] <= (s0 + jnp.arange(Q_BLOCK))[:, None]
        p = jax.nn.softmax(jnp.where(mask, scores, neg), axis=-1).astype(v.dtype)
        outs.append(jnp.einsum('bhqk,bkhd->bqhd', p, v[:, :end]))
    o = jnp.concatenate(outs, axis=1).reshape(bsz, seq, N_HEADS * V_HEAD_DIM)
    return o @ w_o


def swiglu(h, w_gate, w_up, w_down):
    return (jax.nn.silu(h @ w_gate) * (h @ w_up)) @ w_down


def moe_swiglu(h, router, w_gate, w_up, w_down):
    bsz, seq, d = h.shape
    ht = h.reshape(bsz * seq, d)
    probs = jax.nn.softmax((ht @ router).astype(jnp.float32), axis=-1)
    vals, idx = lax.top_k(probs, TOP_K)
    wts = vals / jnp.sum(vals, axis=-1, keepdims=True)
    gates = jnp.einsum('tk,tke->te', wts, jax.nn.one_hot(idx, N_EXPERTS, dtype=jnp.float32)).astype(h.dtype)
    out = jnp.zeros_like(ht)
    for e in range(N_EXPERTS):
        out = out + gates[:, e:e + 1] * swiglu(ht, w_gate[e], w_up[e], w_down[e])
    return out.reshape(bsz, seq, d)


def setup_inputs(seed: int = 0) -> dict:
    key = jax.random.key(seed)
    ks = jax.random.split(key, 24)
    f32 = jnp.float32
    res_scale = (2 * DEPTH) ** -0.5

    def w(k, shape, fan_in, extra=1.0):
        return jax.random.normal(k, shape, f32) * (fan_in ** -0.5) * extra

    def gain(k, shape):
        return 1.0 + 0.02 * jax.random.normal(k, shape, f32)

    x = jax.random.normal(ks[0], (BATCH, SEQ, D_MODEL), f32)
    start = jax.random.randint(ks[1], (BATCH, 1), 0, 4096, dtype=jnp.int32)
    positions = (start + jnp.arange(SEQ, dtype=jnp.int32)[None, :]).astype(jnp.int32)
    return {
        "x": x,
        "positions": positions,
        "norm_mix": gain(ks[2], (DEPTH, D_MODEL)),
        "norm_ffn": gain(ks[3], (DEPTH, D_MODEL)),
        "conv_w_in": w(ks[4], (N_CONV_LAYERS, D_MODEL, 3 * D_MODEL), D_MODEL),
        "conv_w": w(ks[5], (N_CONV_LAYERS, CONV_WIDTH, D_MODEL), CONV_WIDTH),
        "conv_w_out": w(ks[6], (N_CONV_LAYERS, D_MODEL, D_MODEL), D_MODEL, res_scale),
        "mla_w_down": w(ks[7], (N_MLA_LAYERS, D_MODEL, Q_LORA_RANK + KV_LORA_RANK + QK_ROPE_DIM), D_MODEL),
        "mla_q_a_norm": gain(ks[8], (N_MLA_LAYERS, Q_LORA_RANK)),
        "mla_kv_a_norm": gain(ks[9], (N_MLA_LAYERS, KV_LORA_RANK)),
        "mla_w_uq": w(ks[10], (N_MLA_LAYERS, Q_LORA_RANK, N_HEADS * QK_HEAD_DIM), Q_LORA_RANK),
        "mla_w_ukv": w(ks[11], (N_MLA_LAYERS, KV_LORA_RANK, N_HEADS * (QK_NOPE_DIM + V_HEAD_DIM)), KV_LORA_RANK),
        "mla_q_norm": gain(ks[12], (N_MLA_LAYERS, QK_HEAD_DIM)),
        "mla_k_norm": gain(ks[13], (N_MLA_LAYERS, QK_HEAD_DIM)),
        "mla_w_o": w(ks[14], (N_MLA_LAYERS, N_HEADS * V_HEAD_DIM, D_MODEL), N_HEADS * V_HEAD_DIM, res_scale),
        "ffn_w_gate": w(ks[15], (N_DENSE_LAYERS, D_MODEL, D_FF_DENSE), D_MODEL),
        "ffn_w_up": w(ks[16], (N_DENSE_LAYERS, D_MODEL, D_FF_DENSE), D_MODEL),
        "ffn_w_down": w(ks[17], (N_DENSE_LAYERS, D_FF_DENSE, D_MODEL), D_FF_DENSE, res_scale),
        "moe_router": w(ks[18], (N_MOE_LAYERS, D_MODEL, N_EXPERTS), D_MODEL),
        "moe_w_gate": w(ks[19], (N_MOE_LAYERS, N_EXPERTS, D_MODEL, D_FF_EXPERT), D_MODEL),
        "moe_w_up": w(ks[20], (N_MOE_LAYERS, N_EXPERTS, D_MODEL, D_FF_EXPERT), D_MODEL),
        "moe_w_down": w(ks[21], (N_MOE_LAYERS, N_EXPERTS, D_FF_EXPERT, D_MODEL), D_FF_EXPERT, res_scale),
    }


def reference(x, positions, norm_mix, norm_ffn, conv_w_in, conv_w, conv_w_out,
              mla_w_down, mla_q_a_norm, mla_kv_a_norm, mla_w_uq, mla_w_ukv,
              mla_q_norm, mla_k_norm, mla_w_o, ffn_w_gate, ffn_w_up, ffn_w_down,
              moe_router, moe_w_gate, moe_w_up, moe_w_down):
    cos, sin = rope_tables(positions)
    for i in range(DEPTH):
        j = i // 2
        h = rmsnorm(x, norm_mix[i])
        if i % N_MIXERS == 0:
            x = x + short_conv_mixer(h, conv_w_in[j], conv_w[j], conv_w_out[j])
        else:
            x = x + mla_mixer(h, cos, sin, mla_w_down[j], mla_q_a_norm[j], mla_kv_a_norm[j],
                              mla_w_uq[j], mla_w_ukv[j], mla_q_norm[j], mla_k_norm[j], mla_w_o[j])
        h = rmsnorm(x, norm_ffn[i])
        if i % 2 == 0:
            x = x + swiglu(h, ffn_w_gate[j], ffn_w_up[j], ffn_w_down[j])
        else:
            x = x + moe_swiglu(h, moe_router[j], moe_w_gate[j], moe_w_up[j], moe_w_down[j])
    return x
```

```cpp
#include <hip/hip_runtime.h>
#include <cstdio>
#include <cstdint>

#define LAS __attribute__((address_space(3)))
#define GAS __attribute__((address_space(1)))
typedef unsigned short bf16_t;
typedef short bf16x8 __attribute__((ext_vector_type(8)));
typedef short s16x4 __attribute__((ext_vector_type(4)));
typedef float f32x2 __attribute__((ext_vector_type(2)));
typedef float f32x4 __attribute__((ext_vector_type(4)));
typedef float f32x16 __attribute__((ext_vector_type(16)));
typedef unsigned u32x2 __attribute__((ext_vector_type(2)));
typedef unsigned u32x4 __attribute__((ext_vector_type(4)));
typedef GAS unsigned gu32;

constexpr int T = 32768, D = 1024, SEQ = 2048, NBATCH = 16, NH = 8;
constexpr int DQK = 192, DV = 128, QPITCH = NH * DQK  , VPITCH = NH * DV  ;
constexpr int DFF = 2816, DFE = 2048, NE = 8;
constexpr int DOWNP = 768;
constexpr float EPS = 1e-6f;
constexpr float QSCALE = 0.07216878364870322f * 1.4426950408889634f;
constexpr int MAXSLOT = 65536 + 16 * 256;

constexpr size_t MiB = 1u << 20;
constexpr size_t WS_CTL = 0, CTL_ZERO_BYTES = 1 * MiB;
constexpr size_t WS_SSQ = 1 * MiB;
constexpr size_t WS_MSSQ = 3 * MiB;
constexpr size_t WS_KROPE = 6 * MiB;
constexpr size_t WS_COS = 14 * MiB, WS_SIN = 18 * MiB;
constexpr size_t WS_ME = 22 * MiB;
constexpr size_t WS_MW = 22 * MiB + 256 * 1024;
constexpr size_t WS_WGCNT = 23 * MiB;
constexpr size_t WS_TAB = 23 * MiB + 64 * 1024;
constexpr size_t WS_TOK = 24 * MiB;
constexpr size_t WS_WSL = 24 * MiB + 512 * 1024;
constexpr size_t WS_XB = 26 * MiB;
constexpr size_t WS_W = 90 * MiB;
constexpr size_t W_CU = 0, W_B = 4 * MiB, W_OUT = 6 * MiB, W_GU = 8 * MiB, W_DN = 19 * MiB, W_DOWN = 25 * MiB, W_UQ = 26 * MiB + 512 * 1024,
                 W_UKV = 28 * MiB, W_O = 29 * MiB, W_MGU = 32 * MiB, W_MDN = 96 * MiB;
constexpr size_t WS_AR = 218 * MiB;
constexpr size_t AR_V = 0, AR_G = 64 * MiB;
constexpr size_t AR_ACT = 0;
constexpr size_t AR_DOWN = 0, AR_Q = 64 * MiB, AR_K = 160 * MiB, AR_VV = 256 * MiB, AR_O = 0;
constexpr size_t WS_END = 538 * MiB;

constexpr int CW_BAR = 4096;

constexpr int RING_BYTES = 131072;
constexpr int EX_OFF = RING_BYTES;
constexpr int TAB_OFF = EX_OFF + 8192;
constexpr int MISC_OFF = TAB_OFF + 256;
constexpr int LDS_BYTES = MISC_OFF + 128 + 1024;

__device__ __forceinline__ unsigned cvt_pk_bf16(float lo, float hi) { unsigned r; asm volatile("v_cvt_pk_bf16_f32 %0, %1, %2" : "=v"(r) : "v"(lo), "v"(hi)); return r; }
__device__ __forceinline__ u32x4 pack8(f32x4 a, f32x4 b) { u32x4 w; w.x = cvt_pk_bf16(a[0], a[1]); w.y = cvt_pk_bf16(a[2], a[3]); w.z = cvt_pk_bf16(b[0], b[1]); w.w = cvt_pk_bf16(b[2], b[3]); return w; }
__device__ __forceinline__ float sum4(f32x4 a) { return (a[0] + a[1]) + (a[2] + a[3]); }
__device__ __forceinline__ float dot4(f32x4 a) { return (a[0] * a[0] + a[1] * a[1]) + (a[2] * a[2] + a[3] * a[3]); }
__device__ __forceinline__ float rsq(float x) { return 1.0f / __builtin_sqrtf(x); }
__device__ __forceinline__ float bf2f(unsigned short u) { return __builtin_bit_cast(float, (unsigned)u << 16); }
__device__ __forceinline__ float wave_sum(float v) {
#pragma unroll
    for (int o = 1; o < 64; o <<= 1) v += __shfl_xor(v, o);
    return v;
}
__device__ __forceinline__ int lane_id_now() { int l; asm volatile("v_mbcnt_lo_u32_b32 %0, -1, 0\n\tv_mbcnt_hi_u32_b32 %0, -1, %0" : "=v"(l)); return l; }
#define LANE_ID() lane_id_now()
#define LDS_WAIT() asm volatile("s_waitcnt lgkmcnt(0)" ::: "memory")
#define VM_WAIT() asm volatile("s_waitcnt vmcnt(0)" ::: "memory")

#define XB_TMO      128
#define XB_XCNT(j)  (256  + 64 * (j))
#define XB_XSUB(j)  (1280 + 64 * (j))
#define XB_XGEN(j)  (2304 + 64 * (j))
#define XB_TOP      3328
#define XB_TOPGEN   3392
#define XCD_BAR_WORDS 3456
#define XB_SPIN_CAP (1u << 18)

__device__ __forceinline__ unsigned xb_ld(unsigned* p)              { return __hip_atomic_load(p, __ATOMIC_RELAXED, __HIP_MEMORY_SCOPE_AGENT); }
__device__ __forceinline__ unsigned xb_add(unsigned* p, unsigned v) { return __hip_atomic_fetch_add(p, v, __ATOMIC_RELAXED, __HIP_MEMORY_SCOPE_AGENT); }
__device__ __forceinline__ unsigned xb_xcc_id() { return (unsigned)__builtin_amdgcn_s_getreg((3 << 11) | 20) & 0xFu; }
#define XB_SPIN(cond, bar) do { unsigned _sp = 0; while (cond) { __builtin_amdgcn_s_sleep(1); \
    if ((++_sp & 255u) == 0u) { if (xb_ld(&(bar)[XB_TMO])) break; if (_sp > XB_SPIN_CAP) { atomicAdd(&(bar)[XB_TMO], 1u); break; } } } } while (0)

struct XcdBarrier { unsigned* bar; unsigned x; volatile LAS unsigned* st; };

__device__ __forceinline__ XcdBarrier xcd_barrier_post(unsigned* bar, volatile LAS unsigned* st, const int wave) {
    XcdBarrier b; b.bar = bar; b.x = xb_xcc_id(); b.st = st;
    if (wave == 0 && LANE_ID() == 0) (void)xb_add(&bar[XB_XCNT(b.x)], 1u);
    return b;
}
__device__ __forceinline__ void xcd_barrier_complete(unsigned* bar, unsigned x, unsigned& nloc, unsigned& nx) {
    const unsigned G = gridDim.x * gridDim.y * gridDim.z;
    unsigned sum, cnt, mine, sp = 0u;
    for (;;) {
        sum = 0u; cnt = 0u; mine = 0u;
#pragma unroll
        for (unsigned j = 0; j < 16; ++j) { const unsigned c = xb_ld(&bar[XB_XCNT(j)]); sum += c; cnt += (c > 0u) ? 1u : 0u; mine = (j == x) ? c : mine; }
        if (sum == G) break;
        __builtin_amdgcn_s_sleep(1);
        if ((++sp & 255u) == 0u) { if (xb_ld(&bar[XB_TMO])) break; if (sp > XB_SPIN_CAP) { atomicAdd(&bar[XB_TMO], 1u); break; } }
    }
    nloc = mine > 0u ? mine : 1u; nx = cnt > 0u ? cnt : 1u;
}
__device__ __forceinline__ void xcd_barrier(const XcdBarrier& b, const int wave) {
    asm volatile("s_waitcnt vmcnt(0)" ::: "memory");
    __syncthreads();
    if (wave == 0 && LANE_ID() == 0) {
        unsigned* bar = b.bar;
        __builtin_amdgcn_s_waitcnt(0);
        unsigned nloc = b.st[0], nx = b.st[1];
        if (nloc == 0u) { xcd_barrier_complete(bar, b.x, nloc, nx); b.st[0] = nloc; b.st[1] = nx; }
        const unsigned old = xb_add(&bar[XB_XSUB(b.x)], 1u);
        const unsigned gen = old / nloc;
        if (old + 1u == (gen + 1u) * nloc) {
            __builtin_amdgcn_fence(__ATOMIC_RELEASE, "agent");
            asm volatile("s_waitcnt vmcnt(0)" ::: "memory");
            const unsigned og = xb_add(&bar[XB_TOP], 1u);
            const unsigned tg = og / nx;
            if (og + 1u == (tg + 1u) * nx) xb_add(&bar[XB_TOPGEN], 1u);
            else XB_SPIN(xb_ld(&bar[XB_TOPGEN]) == tg, bar);
            __builtin_amdgcn_fence(__ATOMIC_ACQUIRE, "agent");
            xb_add(&bar[XB_XGEN(b.x)], 1u);
            asm volatile("s_waitcnt vmcnt(0)" ::: "memory");
        } else {
            XB_SPIN(xb_ld(&bar[XB_XGEN(b.x)]) == gen, bar);
            __builtin_amdgcn_fence(__ATOMIC_ACQUIRE, "agent");
            asm volatile("s_waitcnt vmcnt(0)" ::: "memory");
        }
    }
    __syncthreads();
}

namespace pg {
constexpr int BM = 256, BK = 64, HALF = 128, HTB = HALF * BK * 2, STAGE_BYTES = 8 * HTB;
__host__ __device__ __forceinline__ int lds_byte(int r, int c) { const int st = (r >> 4) * 2 + (c >> 5), rr = r & 15, cc = c & 31, ob = rr * 64 + cc * 2; return st * 1024 + (ob ^ (((ob >> 9) & 1) << 5)); }
__host__ __device__ __forceinline__ void stage_rc(int b, int& R, int& C) { const int st = b / 1024, sb = b % 1024, swz = sb ^ (((sb >> 9) & 1) << 5); R = (st >> 1) * 16 + swz / 64; C = (st & 1) * 32 + (swz % 64) / 2; }
__host__ __device__ __forceinline__ int perm32(int rho) { const int n = rho >> 4, i = rho & 15; return 8 * (i >> 2) + 4 * n + (i & 3); }

struct Unit { int pm, pn, e; };

__device__ __forceinline__ bool unit_of(long L, int nM, int nN, int& pm, int& pn) {
    const int nwg = nM * nN; if (L >= nwg) return false;
    int wgid = (int)L; { const int q = nwg / 8, r = nwg % 8, xcd = wgid % 8, off = wgid / 8; wgid = (xcd < r ? xcd * (q + 1) : r * (q + 1) + (xcd - r) * q) + off; }
    const int nig = 8 * nN, gid = wgid / nig, fm = gid * 8, gsz = (nM - fm) < 8 ? (nM - fm) : 8;
    pm = fm + ((wgid % nig) % gsz); pn = (wgid % nig) / gsz; return true;
}

struct SchedPlain {
    const bf16_t* A; int lda; const bf16_t* Bt; int K; int nM, nN, G, c;
    static constexpr bool GATHER = false;
    __device__ __forceinline__ bool next(int i, Unit& u) const { u.e = 0; return unit_of((long)i * G + c, nM, nN, u.pm, u.pn); }
    __device__ __forceinline__ void addrA(const Unit& u, const int (&R)[2], const int (&C)[2], const char*& base, unsigned (&v)[2][2]) const {
        base = (const char*)(A + (size_t)u.pm * BM * lda);
#pragma unroll
        for (int h = 0; h < 2; ++h)
#pragma unroll
            for (int i = 0; i < 2; ++i) v[h][i] = (unsigned)((h * HALF + R[i]) * lda + C[i]) * 2u;
    }
    __device__ __forceinline__ const char* ptrB(const Unit& u) const { return (const char*)(Bt + (size_t)u.pn * BM * K); }
};
struct SchedMoeGU {
    const bf16_t* A; const int* tok; const bf16_t* Bt; const LAS int* pfx; int nM, G, c;
    static constexpr bool GATHER = true;
    __device__ __forceinline__ int list_of(int mt) const { int l = 0;
#pragma unroll
        for (int k = 1; k < 16; ++k) l += (mt >= pfx[k]) ? 1 : 0;
        return l; }
    __device__ __forceinline__ bool next(int i, Unit& u) const { if (!unit_of((long)i * G + c, nM, 16, u.pm, u.pn)) return false; u.e = list_of(u.pm) & 7; return true; }
    __device__ __forceinline__ void addrA(const Unit& u, const int (&R)[2], const int (&C)[2], const char*& base, unsigned (&v)[2][2]) const {
        base = (const char*)A;
#pragma unroll
        for (int h = 0; h < 2; ++h)
#pragma unroll
            for (int i = 0; i < 2; ++i) { int t = tok[u.pm * BM + h * HALF + R[i]]; t = t < 0 ? 0 : t; v[h][i] = (unsigned)(t * D + C[i]) * 2u; }
    }
    __device__ __forceinline__ const char* ptrB(const Unit& u) const { return (const char*)(Bt + ((size_t)u.e * 4096 + (size_t)u.pn * BM) * D); }
};
struct SchedMoeDn {
    const bf16_t* A; const bf16_t* Bt; const LAS int* pfx; int lo, nM, G, c;
    static constexpr bool GATHER = false;
    __device__ __forceinline__ int list_of(int mt) const { int l = 0;
#pragma unroll
        for (int k = 1; k < 16; ++k) l += (mt >= pfx[k]) ? 1 : 0;
        return l; }
    __device__ __forceinline__ bool next(int i, Unit& u) const { if (!unit_of((long)i * G + c, nM, 4, u.pm, u.pn)) return false; u.pm += lo; u.e = list_of(u.pm) & 7; return true; }
    __device__ __forceinline__ void addrA(const Unit& u, const int (&R)[2], const int (&C)[2], const char*& base, unsigned (&v)[2][2]) const {
        base = (const char*)(A + (size_t)u.pm * BM * DFE);
#pragma unroll
        for (int h = 0; h < 2; ++h)
#pragma unroll
            for (int i = 0; i < 2; ++i) v[h][i] = (unsigned)((h * HALF + R[i]) * DFE + C[i]) * 2u;
    }
    __device__ __forceinline__ const char* ptrB(const Unit& u) const { return (const char*)(Bt + ((size_t)u.e * 1024 + (size_t)u.pn * BM) * DFE); }
};

template <class Epi, class Sched>
__device__ __forceinline__ void gemm_phase(LAS unsigned char* lds, const int K, const Sched& S, const Epi& E, const int wave) {
    int tid = wave * 64 + LANE_ID(); asm volatile("" : "+v"(tid));
    const int wid = wave, lane = tid & 63, wr = wid >> 2, wc = wid & 3, fr = lane & 15, fq = lane >> 4;
    int nt = K / BK; asm volatile("" : "+s"(nt));
    int R[2], C[2]; unsigned voffB[2];
#pragma unroll
    for (int i = 0; i < 2; ++i) { stage_rc(tid * 16 + i * 8192, R[i], C[i]); const int Rb = (R[i] & ~31) + perm32(R[i] & 31); voffB[i] = (unsigned)(Rb * K + C[i]) * 2u; }
    const size_t kstep = (size_t)(BK * 2);
    const size_t hstepB = (size_t)HALF * K * 2;
    const unsigned ldsw = (unsigned)wid * 1024u;
    const int aoff = lds_byte(wr * 64 + fr, fq * 8), boff = lds_byte(wc * 32 + fr, fq * 8);
#define PG_SA(b, h) (((b) * 2 + (h)) * HTB)
#define PG_SB(b, h) ((4 + (b) * 2 + (h)) * HTB)
#define PG_STAGE(bufoff, gbase, voff) do { _Pragma("unroll") for (int _i = 0; _i < 2; ++_i) \
        __builtin_amdgcn_global_load_lds((const unsigned*)((const char*)(gbase) + (voff)[_i]), (LAS unsigned*)(lds + (bufoff) + ldsw + _i * 8192), 16, 0, 0); } while (0)
#define PG_LDA(dst, b, h) do { _Pragma("unroll") for (int m = 0; m < 4; ++m) _Pragma("unroll") for (int k = 0; k < 2; ++k) dst[m][k] = *(const LAS bf16x8*)(lds + PG_SA(b, h) + aoff + m * 2048 + k * 1024); } while (0)
#define PG_LDB(dst, b, h) do { _Pragma("unroll") for (int n = 0; n < 2; ++n) _Pragma("unroll") for (int k = 0; k < 2; ++k) dst[n][k] = *(const LAS bf16x8*)(lds + PG_SB(b, h) + boff + n * 2048 + k * 1024); } while (0)
#define PG_MMA(ai, bj, At, Bt) do { __builtin_amdgcn_s_setprio(1); _Pragma("unroll") for (int m = 0; m < 4; ++m) _Pragma("unroll") for (int n = 0; n < 2; ++n) _Pragma("unroll") for (int k = 0; k < 2; ++k) \
        acc[ai][bj][m][n] = __builtin_amdgcn_mfma_f32_16x16x32_bf16(Bt[n][k], At[m][k], acc[ai][bj][m][n], 0, 0, 0); __builtin_amdgcn_s_setprio(0); } while (0)
#define PG_WAIT_V(n) asm volatile("s_waitcnt vmcnt(" #n ")" ::: "memory")
#define PG_WAIT_L(n) asm volatile("s_waitcnt lgkmcnt(" #n ")" ::: "memory")
#define PG_BAR __builtin_amdgcn_s_barrier()
#define PG_SCHED __builtin_amdgcn_sched_barrier(0)
    Unit cur, nxt; int ui = 0;
    if (!S.next(0, cur)) return;
    f32x4 acc[2][2][4][2];
#pragma unroll
    for (int a = 0; a < 2; ++a)
#pragma unroll
        for (int b = 0; b < 2; ++b)
#pragma unroll
            for (int m = 0; m < 4; ++m)
#pragma unroll
                for (int n = 0; n < 2; ++n) acc[a][b][m][n] = (f32x4){0.f, 0.f, 0.f, 0.f};
    bf16x8 At[4][2], B0[2][2], B1[2][2];
    unsigned vA[2][2], vN[2][2];
    const char* cA; S.addrA(cur, R, C, cA, vA);
    const char* cB = S.ptrB(cur);
    PG_STAGE(PG_SB(0, 0), cB, voffB); PG_STAGE(PG_SB(0, 1), cB + hstepB, voffB); PG_STAGE(PG_SA(0, 0), cA, vA[0]); PG_STAGE(PG_SA(0, 1), cA, vA[1]);
    if (wr == 1) PG_BAR;
    PG_WAIT_V(2); PG_BAR;
    PG_STAGE(PG_SB(1, 0), cB + kstep, voffB); PG_STAGE(PG_SA(1, 0), cA + kstep, vA[0]); PG_STAGE(PG_SB(1, 1), cB + hstepB + kstep, voffB);
    PG_WAIT_V(6); PG_BAR;
    for (;;) {
        const bool has_next = S.next(ui + 1, nxt);
        const char* nA = cA; const char* nB = cB;
#pragma unroll
        for (int h = 0; h < 2; ++h)
#pragma unroll
            for (int i = 0; i < 2; ++i) vN[h][i] = vA[h][i];
        if (has_next) { S.addrA(nxt, R, C, nA, vN); nB = S.ptrB(nxt); }
        for (int t = 0; t < nt; t += 2) {
            const bool last = (t == nt - 2);
            const char* a1 = cA + (size_t)(t + 1) * kstep;
            const char* a2 = last ? nA : cA + (size_t)(t + 2) * kstep; const char* b2 = last ? nB : cB + (size_t)(t + 2) * kstep;
            const char* a3 = a2 + kstep; const char* b3 = b2 + kstep;
            unsigned w0[2], w1[2];
            if constexpr (Sched::GATHER) { w0[0] = last ? vN[0][0] : vA[0][0]; w0[1] = last ? vN[0][1] : vA[0][1]; w1[0] = last ? vN[1][0] : vA[1][0]; w1[1] = last ? vN[1][1] : vA[1][1]; }
            else { w0[0] = vA[0][0]; w0[1] = vA[0][1]; w1[0] = vA[1][0]; w1[1] = vA[1][1]; }
            PG_LDB(B0, 0, 0); PG_LDB(B1, 0, 1); PG_SCHED; PG_LDA(At, 0, 0); PG_STAGE(PG_SA(1, 1), a1, vA[1]);
            PG_WAIT_V(8); PG_WAIT_L(0); PG_BAR; PG_MMA(0, 0, At, B0); PG_MMA(0, 1, At, B1); PG_BAR; PG_SCHED;
            PG_LDA(At, 0, 1); PG_STAGE(PG_SB(0, 0), b2, voffB); PG_STAGE(PG_SB(0, 1), b2 + hstepB, voffB); PG_STAGE(PG_SA(0, 0), a2, w0);
            PG_WAIT_V(8); PG_WAIT_L(0); PG_BAR; PG_MMA(1, 0, At, B0); PG_MMA(1, 1, At, B1); PG_BAR; PG_SCHED;
            PG_LDB(B0, 1, 0); PG_LDB(B1, 1, 1); PG_SCHED; PG_LDA(At, 1, 0); PG_STAGE(PG_SA(0, 1), a2, w1);
            PG_WAIT_V(8); PG_WAIT_L(0); PG_BAR; PG_MMA(0, 0, At, B0); PG_MMA(0, 1, At, B1); PG_BAR; PG_SCHED;
            PG_LDA(At, 1, 1); PG_STAGE(PG_SB(1, 0), b3, voffB); PG_STAGE(PG_SB(1, 1), b3 + hstepB, voffB); PG_STAGE(PG_SA(1, 0), a3, w0);
            PG_WAIT_V(8); PG_WAIT_L(0); PG_BAR; PG_MMA(1, 0, At, B0); PG_MMA(1, 1, At, B1); PG_BAR; PG_SCHED;
        }
        if (wr == 0) PG_BAR;
        { const int l2 = LANE_ID(); E(acc, cur, wr, wc, l2 & 15, l2 >> 4); }
        if (!has_next) break;
#pragma unroll
        for (int a = 0; a < 2; ++a)
#pragma unroll
            for (int b = 0; b < 2; ++b)
#pragma unroll
                for (int m = 0; m < 4; ++m)
#pragma unroll
                    for (int n = 0; n < 2; ++n) acc[a][b][m][n] = (f32x4){0.f, 0.f, 0.f, 0.f};
        cur = nxt; cA = nA; cB = nB; ++ui;
#pragma unroll
        for (int h = 0; h < 2; ++h)
#pragma unroll
            for (int i = 0; i < 2; ++i) vA[h][i] = vN[h][i];
        if (wr == 1) PG_BAR;
    }
    PG_WAIT_V(0);
    PG_BAR;
#undef PG_SA
#undef PG_SB
#undef PG_STAGE
#undef PG_LDA
#undef PG_LDB
#undef PG_MMA
#undef PG_WAIT_V
#undef PG_WAIT_L
#undef PG_BAR
#undef PG_SCHED
}

typedef f32x4 Acc[2][2][4][2];
#define EPI_FENCE() asm volatile("" ::: "memory")
#define EPI_BAR() do { LDS_WAIT(); __builtin_amdgcn_s_barrier(); asm volatile("" ::: "memory"); } while (0)
__device__ __forceinline__ float rstd4(const float* p, float inv_n) { return rsq(sum4(*(const f32x4*)p) * inv_n + EPS); }
__device__ __forceinline__ float fq_sum(float s) { s += __shfl_xor(s, 16); s += __shfl_xor(s, 32); return s; }

struct EpiCU {
    const float* ssq; bf16_t* V;
    __device__ __forceinline__ void operator()(Acc& acc, const Unit& u_, int wr, int wc, int fr, int fq) const {
        Unit u = u_; asm volatile("" : "+s"(u.pm), "+s"(u.pn), "+v"(fr), "+v"(fq));
        const int cg = wc * 32 + fq * 8;
#pragma unroll
        for (int ai = 0; ai < 2; ++ai)
#pragma unroll
            for (int m = 0; m < 4; ++m) {
                const int row = u.pm * BM + ai * HALF + wr * 64 + m * 16 + fr;
                const float rs = rstd4(ssq + (size_t)row * 4, 1.0f / D), r2 = rs * rs;
                const f32x4 v0 = acc[ai][0][m][0] * acc[ai][1][m][0] * r2, v1 = acc[ai][0][m][1] * acc[ai][1][m][1] * r2;
                *(u32x4*)(V + (size_t)row * D + u.pn * HALF + cg) = pack8(v0, v1);
            }
    }
};
struct EpiB {
    const float* ssq; const bf16_t* V; const float* cw; bf16_t* Gout;
    __device__ __forceinline__ void operator()(Acc& acc, const Unit& u_, int wr, int wc, int fr, int fq) const {
        Unit u = u_; asm volatile("" : "+s"(u.pm), "+s"(u.pn), "+v"(fr), "+v"(fq));
        float rs[2][4];
#pragma unroll
        for (int ai = 0; ai < 2; ++ai)
#pragma unroll
            for (int m = 0; m < 4; ++m) rs[ai][m] = rstd4(ssq + (size_t)(u.pm * BM + ai * HALF + wr * 64 + m * 16 + fr) * 4, 1.0f / D);
#pragma unroll
        for (int bj = 0; bj < 2; ++bj) {
            const int col = u.pn * BM + bj * HALF + wc * 32 + fq * 8;
            f32x4 w[3][2];
#pragma unroll
            for (int k = 0; k < 3; ++k) { w[k][0] = *(const f32x4*)(cw + k * D + col); w[k][1] = *(const f32x4*)(cw + k * D + col + 4); }
#pragma unroll
            for (int ai = 0; ai < 2; ++ai)
#pragma unroll
                for (int m = 0; m < 4; ++m) {
                    const int row = u.pm * BM + ai * HALF + wr * 64 + m * 16 + fr, s = row & (SEQ - 1);
                    const bf16_t* vp = V + (size_t)row * D + col;
                    const u32x4 z = (u32x4){0u, 0u, 0u, 0u};
                    const u32x4 x2 = *(const u32x4*)vp;
                    const u32x4 x1 = s >= 1 ? *(const u32x4*)(vp - D) : z;
                    const u32x4 x0 = s >= 2 ? *(const u32x4*)(vp - 2 * D) : z;
                    f32x4 c0, c1;
#pragma unroll
                    for (int q = 0; q < 4; ++q) {
                        const unsigned a0 = x0[q], a1 = x1[q], a2 = x2[q];
                        const float lo = __builtin_bit_cast(float, a0 << 16) * w[0][q >> 1][(q & 1) * 2] + __builtin_bit_cast(float, a1 << 16) * w[1][q >> 1][(q & 1) * 2] + __builtin_bit_cast(float, a2 << 16) * w[2][q >> 1][(q & 1) * 2];
                        const float hi = __builtin_bit_cast(float, a0 & 0xffff0000u) * w[0][q >> 1][(q & 1) * 2 + 1] + __builtin_bit_cast(float, a1 & 0xffff0000u) * w[1][q >> 1][(q & 1) * 2 + 1] + __builtin_bit_cast(float, a2 & 0xffff0000u) * w[2][q >> 1][(q & 1) * 2 + 1];
                        if (q < 2) { c0[(q & 1) * 2] = lo; c0[(q & 1) * 2 + 1] = hi; } else { c1[(q & 1) * 2] = lo; c1[(q & 1) * 2 + 1] = hi; }
                    }
                    const f32x4 g0 = acc[ai][bj][m][0] * rs[ai][m] * c0, g1 = acc[ai][bj][m][1] * rs[ai][m] * c1;
                    *(u32x4*)(Gout + (size_t)row * D + col) = pack8(g0, g1);
                    if (m & 1) EPI_FENCE();
                }
        }
    }
};
struct EpiRes {
    const float* base; float* out; bf16_t* XB; float* ssq; LAS float* ex;
    __device__ __forceinline__ void operator()(Acc& acc, const Unit& u_, int wr, int wc, int fr, int fq) const {
        Unit u = u_; asm volatile("" : "+s"(u.pm), "+s"(u.pn), "+v"(fr), "+v"(fq));
#pragma unroll
        for (int ai = 0; ai < 2; ++ai)
#pragma unroll
            for (int m = 0; m < 4; ++m) {
                const int rl = ai * HALF + wr * 64 + m * 16 + fr, row = u.pm * BM + rl; float ss = 0.f;
#pragma unroll
                for (int bj = 0; bj < 2; ++bj) {
                    const size_t o = (size_t)row * D + u.pn * BM + bj * HALF + wc * 32 + fq * 8;
                    const f32x4 x0 = *(const f32x4*)(base + o) + acc[ai][bj][m][0], x1 = *(const f32x4*)(base + o + 4) + acc[ai][bj][m][1];
                    *(f32x4*)(out + o) = x0; *(f32x4*)(out + o + 4) = x1;
                    *(u32x4*)(XB + o) = pack8(x0, x1);
                    ss += dot4(x0) + dot4(x1);
                }
                ss = fq_sum(ss);
                if (fq == 0) ex[rl * 4 + wc] = ss;
                if (m & 1) EPI_FENCE();
            }
        EPI_BAR();
        const int tx = (wr * 4 + wc) * 64 + fq * 16 + fr;
        if (tx < 256) ssq[(size_t)(u.pm * BM + tx) * 4 + u.pn] = sum4(*(const LAS f32x4*)(ex + tx * 4));
    }
};
__device__ __forceinline__ f32x4 silu_mul(f32x4 g, f32x4 u) {
    f32x4 r;
#pragma unroll
    for (int j = 0; j < 4; ++j) r[j] = g[j] * u[j] * __builtin_amdgcn_rcpf(1.0f + __builtin_amdgcn_exp2f(-1.4426950408889634f * g[j]));
    return r;
}
template <bool MOE> struct EpiGU {
    const float* ssq; bf16_t* act; int ldc; const int* tok;
    __device__ __forceinline__ void operator()(Acc& acc, const Unit& u_, int wr, int wc, int fr, int fq) const {
        Unit u = u_; asm volatile("" : "+s"(u.pm), "+s"(u.pn), "+v"(fr), "+v"(fq));
        const int cg = wc * 32 + fq * 8;
#pragma unroll
        for (int ai = 0; ai < 2; ++ai)
#pragma unroll
            for (int m = 0; m < 4; ++m) {
                const int row = u.pm * BM + ai * HALF + wr * 64 + m * 16 + fr;
                int srow = row; if (MOE) { srow = tok[row]; srow = srow < 0 ? 0 : srow; }
                const float rs = rstd4(ssq + (size_t)srow * 4, 1.0f / D);
                const f32x4 a0 = silu_mul(acc[ai][0][m][0] * rs, acc[ai][1][m][0] * rs), a1 = silu_mul(acc[ai][0][m][1] * rs, acc[ai][1][m][1] * rs);
                *(u32x4*)(act + (size_t)row * ldc + u.pn * HALF + cg) = pack8(a0, a1);
            }
    }
};
struct EpiMoeDn {
    const int* tok; const float* wsl; float* out; bf16_t* XB; float* ssq; LAS float* ex;
    __device__ __forceinline__ void operator()(Acc& acc, const Unit& u_, int wr, int wc, int fr, int fq) const {
        Unit u = u_; asm volatile("" : "+s"(u.pm), "+s"(u.pn), "+v"(fr), "+v"(fq));
#pragma unroll
        for (int ai = 0; ai < 2; ++ai)
#pragma unroll
            for (int m = 0; m < 4; ++m) {
                const int rl = ai * HALF + wr * 64 + m * 16 + fr, slot = u.pm * BM + rl;
                const int tk = tok[slot]; const float w = wsl[slot]; float ss = 0.f;
                if (tk >= 0) {
#pragma unroll
                    for (int bj = 0; bj < 2; ++bj) {
                        const size_t o = (size_t)tk * D + u.pn * BM + bj * HALF + wc * 32 + fq * 8;
                        const f32x4 x0 = *(const f32x4*)(out + o) + acc[ai][bj][m][0] * w, x1 = *(const f32x4*)(out + o + 4) + acc[ai][bj][m][1] * w;
                        *(f32x4*)(out + o) = x0; *(f32x4*)(out + o + 4) = x1;
                        if (XB) { *(u32x4*)(XB + o) = pack8(x0, x1); ss += dot4(x0) + dot4(x1); }
                    }
                }
                if (XB) { ss = fq_sum(ss); if (fq == 0) ex[rl * 4 + wc] = ss; }
                if (m & 1) EPI_FENCE();
            }
        if (XB) {
            EPI_BAR();
            const int tx = (wr * 4 + wc) * 64 + fq * 16 + fr;
            if (tx < 256) { const int tk = tok[u.pm * BM + tx]; if (tk >= 0) ssq[(size_t)tk * 4 + u.pn] = sum4(*(const LAS f32x4*)(ex + tx * 4)); }
        }
    }
};
struct EpiDown {
    const float* ssq; bf16_t* down; float* krope; float* mssq; LAS float* ex;
    __device__ __forceinline__ void operator()(Acc& acc, const Unit& u_, int wr, int wc, int fr, int fq) const {
        Unit u = u_; asm volatile("" : "+s"(u.pm), "+s"(u.pn), "+v"(fr), "+v"(fq));
        const int cg = wc * 32 + fq * 8;
#pragma unroll
        for (int ai = 0; ai < 2; ++ai)
#pragma unroll
            for (int m = 0; m < 4; ++m) {
                const int rl = ai * HALF + wr * 64 + m * 16 + fr, row = u.pm * BM + rl;
                const float rs = rstd4(ssq + (size_t)row * 4, 1.0f / D);
#pragma unroll
                for (int bj = 0; bj < 2; ++bj) {
                    const int seg = u.pn * 2 + bj;
                    const f32x4 y0 = acc[ai][bj][m][0] * rs, y1 = acc[ai][bj][m][1] * rs;
                    const float ss = fq_sum(dot4(y0) + dot4(y1));
                    if (fq == 0) ex[(bj * 256 + rl) * 4 + wc] = ss;
                    if (seg < 5) *(u32x4*)(down + (size_t)row * DOWNP + u.pn * BM + bj * HALF + cg) = pack8(y0, y1);
                    else if (wc < 2) { *(f32x4*)(krope + (size_t)row * 64 + cg) = y0; *(f32x4*)(krope + (size_t)row * 64 + cg + 4) = y1; }
                }
            }
        EPI_BAR();
        { const int tx = (wr * 4 + wc) * 64 + fq * 16 + fr, bj = tx >> 8, rl = tx & 255; const int seg = u.pn * 2 + bj, si = seg < 3 ? seg : (seg == 5 ? 3 : seg + 1); mssq[(size_t)(u.pm * BM + rl) * 8 + si] = sum4(*(const LAS f32x4*)(ex + (bj * 256 + rl) * 4)); }
    }
};
struct EpiQ {
    const float* mssq; const float* gq; const float* cosT; const float* sinT; bf16_t* Q; LAS float* ex;
    __device__ __forceinline__ void operator()(Acc& acc, const Unit& u_, int wr, int wc, int fr, int fq) const {
        Unit u = u_; asm volatile("" : "+s"(u.pm), "+s"(u.pn), "+v"(fr), "+v"(fq));
        const int cg = wc * 32 + fq * 8;
#pragma unroll
        for (int ai = 0; ai < 2; ++ai)
#pragma unroll
            for (int m = 0; m < 4; ++m) {
                const int rl = ai * HALF + wr * 64 + m * 16 + fr, row = u.pm * BM + rl;
                const f32x4 a = *(const f32x4*)(mssq + (size_t)row * 8);
                const float rs = rsq(((a[0] + a[1]) + a[2]) * (1.0f / 384.0f) + EPS);
                float ss = 0.f;
#pragma unroll
                for (int bj = 0; bj < 2; ++bj)
#pragma unroll
                    for (int n = 0; n < 2; ++n) { acc[ai][bj][m][n] = acc[ai][bj][m][n] * rs; ss += dot4(acc[ai][bj][m][n]); }
                ss = fq_sum(ss);
                if (fq == 0) ex[rl * 4 + wc] = ss;
                if (m & 1) EPI_FENCE();
            }
        EPI_BAR();
        const f32x4 g0 = *(const f32x4*)(gq + cg), g1 = *(const f32x4*)(gq + cg + 4);
        const int i0 = wc * 16 + fq * 4;
        f32x4 gr1 = (f32x4){0.f, 0.f, 0.f, 0.f}, gr2 = gr1;
        if (wc < 2) { gr1 = *(const f32x4*)(gq + 128 + i0); gr2 = *(const f32x4*)(gq + 160 + i0); }
#pragma unroll
        for (int ai = 0; ai < 2; ++ai)
#pragma unroll
            for (int m = 0; m < 4; ++m) {
                const int rl = ai * HALF + wr * 64 + m * 16 + fr, row = u.pm * BM + rl;
                const f32x4 e = *(const LAS f32x4*)(ex + rl * 4);
                const float rh = rsq(sum4(e) * (1.0f / DQK) + EPS) * QSCALE;
                bf16_t* qp = Q + (size_t)row * QPITCH + u.pn * DQK;
                *(u32x4*)(qp + cg) = pack8(acc[ai][0][m][0] * g0 * rh, acc[ai][0][m][1] * g1 * rh);
                if (wc < 2) {
                    const f32x4 x1 = acc[ai][1][m][0] * gr1 * rh, x2 = acc[ai][1][m][1] * gr2 * rh;
                    const f32x4 cs = *(const f32x4*)(cosT + (size_t)row * 32 + i0), sn = *(const f32x4*)(sinT + (size_t)row * 32 + i0);
                    const f32x4 o1 = x1 * cs - x2 * sn, o2 = x2 * cs + x1 * sn;
                    u32x2 w1, w2; w1.x = cvt_pk_bf16(o1[0], o1[1]); w1.y = cvt_pk_bf16(o1[2], o1[3]); w2.x = cvt_pk_bf16(o2[0], o2[1]); w2.y = cvt_pk_bf16(o2[2], o2[3]);
                    *(u32x2*)(qp + 128 + i0) = w1; *(u32x2*)(qp + 160 + i0) = w2;
                }
                EPI_FENCE();
            }
    }
};
struct EpiKV {
    const float* mssq; const float* krope; const float* gk; const float* cosT; const float* sinT; bf16_t* Kc; bf16_t* Vc; LAS float* ex;
    __device__ __forceinline__ void operator()(Acc& acc, const Unit& u_, int wr, int wc, int fr, int fq) const {
        Unit u = u_; asm volatile("" : "+s"(u.pm), "+s"(u.pn), "+v"(fr), "+v"(fq));
        const int cg = wc * 32 + fq * 8;
#pragma unroll
        for (int ai = 0; ai < 2; ++ai)
#pragma unroll
            for (int m = 0; m < 4; ++m) {
                const int rl = ai * HALF + wr * 64 + m * 16 + fr, row = u.pm * BM + rl;
                const f32x2 a = *(const f32x2*)(mssq + (size_t)row * 8 + 4);
                const float rs = rsq((a[0] + a[1]) * (1.0f / 256.0f) + EPS);
#pragma unroll
                for (int bj = 0; bj < 2; ++bj)
#pragma unroll
                    for (int n = 0; n < 2; ++n) acc[ai][bj][m][n] = acc[ai][bj][m][n] * rs;
                const float ss = fq_sum(dot4(acc[ai][0][m][0]) + dot4(acc[ai][0][m][1]));
                if (fq == 0) ex[rl * 4 + wc] = ss;
                if (m & 1) EPI_FENCE();
            }
        EPI_BAR();
        const f32x4 g0 = *(const f32x4*)(gk + cg), g1 = *(const f32x4*)(gk + cg + 4);
        const int i0 = wc * 8 + fq * 2;
        const f32x2 gr1 = *(const f32x2*)(gk + 128 + i0), gr2 = *(const f32x2*)(gk + 160 + i0);
#pragma unroll
        for (int ai = 0; ai < 2; ++ai)
#pragma unroll
            for (int m = 0; m < 4; ++m) {
                const int rl = ai * HALF + wr * 64 + m * 16 + fr, row = u.pm * BM + rl;
                const f32x4 e = *(const LAS f32x4*)(ex + rl * 4);
                const float rp = mssq[(size_t)row * 8 + 3];
                const float rk = rsq((sum4(e) + rp) * (1.0f / DQK) + EPS);
                bf16_t* kp = Kc + (size_t)row * QPITCH + u.pn * DQK;
                *(u32x4*)(kp + cg) = pack8(acc[ai][0][m][0] * g0 * rk, acc[ai][0][m][1] * g1 * rk);
                *(u32x4*)(Vc + (size_t)row * VPITCH + u.pn * DV + cg) = pack8(acc[ai][1][m][0], acc[ai][1][m][1]);
                const f32x2 x1 = *(const f32x2*)(krope + (size_t)row * 64 + i0) * gr1 * rk, x2 = *(const f32x2*)(krope + (size_t)row * 64 + 32 + i0) * gr2 * rk;
                const f32x2 cs = *(const f32x2*)(cosT + (size_t)row * 32 + i0), sn = *(const f32x2*)(sinT + (size_t)row * 32 + i0);
                const f32x2 o1 = x1 * cs - x2 * sn, o2 = x2 * cs + x1 * sn;
                *(unsigned*)(kp + 128 + i0) = cvt_pk_bf16(o1[0], o1[1]); *(unsigned*)(kp + 160 + i0) = cvt_pk_bf16(o2[0], o2[1]);
                EPI_FENCE();
            }
    }
};
}

namespace att {
constexpr int KP = 400, KT = 64 * KP  , VT = 16384;
constexpr int OFF_V = 0, OFF_K = 2 * VT, OFF_WS = OFF_K + 2 * KT, BYTES = OFF_WS + 8 * 256;
constexpr float THR2 = 8.0f;
#define SBAR() __builtin_amdgcn_sched_barrier(0)
__device__ __forceinline__ int v_st(int k, int c) { const int kk = (k & ~0xC) | ((k & 4) << 1) | ((k & 8) >> 1); return ((kk >> 3) * 4 + (c >> 5)) * 512 + ((kk & 7) * 32 + (c & 31)) * 2; }
__device__ __forceinline__ int v_rd_base(int lane) { return ((lane & 3) << 3) | (((lane >> 2) & 3) << 6) | (((lane >> 4) & 1) << 5) | (((lane >> 5) & 1) << 8); }
constexpr int v_rd_off(int d0, int ks, int half) { return d0 * 512 + ks * 4096 + half * 2048; }
__device__ __forceinline__ int crow(int r, int hi) { return (r & 3) + 8 * (r >> 2) + 4 * hi; }
__device__ __forceinline__ void mask_tile(f32x16& p0, f32x16& p1, int dq) {
    const float NEG = -__builtin_inff();
#pragma unroll
    for (int r = 0; r < 16; ++r) {
        const int c = (r & 3) + 8 * (r >> 2);
        if (dq - c < 0) p0[r] = NEG;
        if (dq - c - 32 < 0) p1[r] = NEG;
    }
}
__device__ __forceinline__ void attn_unit(const bf16_t* __restrict__ Q, const bf16_t* __restrict__ K, const bf16_t* __restrict__ V, bf16_t* __restrict__ O, int b, int h, int qb, LAS unsigned char* lds, const int wave) {
    int lane = LANE_ID(); asm volatile("" : "+v"(lane));
    const int wid = wave, r32 = lane & 31, hi = lane >> 5;
    const int q0 = qb * 256, NT = (q0 + 256) / 64, qlo = q0 + wid * 32;
    const size_t tok0 = (size_t)b * SEQ;
    unsigned kg[4], vg[2];
#pragma unroll
    for (int i = 0; i < 4; ++i) { const int pc = (wid + 8 * i) * 64 + lane, key = pc / 25; int cc = pc - key * 25; cc = cc == 24 ? 0 : cc; kg[i] = (unsigned)((key & 63) * QPITCH + cc * 8) * 2u; }
#pragma unroll
    for (int i = 0; i < 2; ++i) { const int pc = (wid + 8 * i) * 64 + lane, st = pc >> 5, w = pc & 31, kk = (st >> 2) * 8 + (w >> 2), c = (st & 3) * 32 + (w & 3) * 8;
        const int k = (kk & ~0xC) | ((kk & 4) << 1) | ((kk & 8) >> 1); vg[i] = (unsigned)(k * VPITCH + c) * 2u; }
    const char* Kh = (const char*)(K + tok0 * QPITCH + h * DQK); const char* Vh = (const char*)(V + tok0 * VPITCH + h * DV);
    LAS unsigned char* Vl = lds + OFF_V; LAS unsigned char* Kl = lds + OFF_K;
    LAS float* wsf = (LAS float*)(lds + OFF_WS) + wid * 64;
#define ADMA(t, bf) do { const char* kt_ = Kh + (size_t)(t) * 64 * QPITCH * 2; const char* vt_ = Vh + (size_t)(t) * 64 * VPITCH * 2; \
        _Pragma("unroll") for (int i = 0; i < 3; ++i) __builtin_amdgcn_global_load_lds((const unsigned*)(kt_ + kg[i]), (LAS unsigned*)(Kl + (bf) * KT + (wid + 8 * i) * 1024), 16, 0, 0); \
        if (wid == 0) __builtin_amdgcn_global_load_lds((const unsigned*)(kt_ + kg[3]), (LAS unsigned*)(Kl + (bf) * KT + 24 * 1024), 16, 0, 0); \
        _Pragma("unroll") for (int i = 0; i < 2; ++i) __builtin_amdgcn_global_load_lds((const unsigned*)(vt_ + vg[i]), (LAS unsigned*)(Vl + (bf) * VT + (wid + 8 * i) * 1024), 16, 0, 0); } while (0)
    bf16x8 qr[12];
    { const bf16_t* qp = Q + (tok0 + qlo + r32) * QPITCH + h * DQK + hi * 8;
#pragma unroll
      for (int d0 = 0; d0 < 12; ++d0) qr[d0] = *(const bf16x8*)(qp + d0 * 16); }
    ADMA(0, 0);
    VM_WAIT(); __builtin_amdgcn_s_barrier(); asm volatile("" ::: "memory");
    float m_reg = -1e30f, l_reg = 0.f; f32x16 o[4];
#pragma unroll
    for (int d = 0; d < 4; ++d) o[d] = f32x16{};
    const int kfb = r32 * KP + hi * 16;
    const int vrb = (int)(uintptr_t)Vl + v_rd_base(lane);
    for (int t = 0; t < NT; ++t) {
        const int bf = t & 1;
        if (t + 1 < NT) ADMA(t + 1, bf ^ 1);
        if (64 * t <= qlo + 31) {
            f32x16 p0 = f32x16{}, p1 = f32x16{};
            { const LAS unsigned char* kb = Kl + bf * KT + kfb;
#pragma unroll
              for (int d0 = 0; d0 < 12; ++d0) {
                  const bf16x8 b0 = *(const LAS bf16x8*)(kb + d0 * 32), b1 = *(const LAS bf16x8*)(kb + 32 * KP + d0 * 32);
                  p0 = __builtin_amdgcn_mfma_f32_32x32x16_bf16(b0, qr[d0], p0, 0, 0, 0);
                  p1 = __builtin_amdgcn_mfma_f32_32x32x16_bf16(b1, qr[d0], p1, 0, 0, 0); } }
            if (64 * t + 63 > qlo) mask_tile(p0, p1, qlo + r32 - 4 * hi - 64 * t);
            float pmax = p0[0];
#pragma unroll
            for (int r = 1; r < 16; ++r) pmax = fmaxf(pmax, p0[r]);
#pragma unroll
            for (int r = 0; r < 16; ++r) pmax = fmaxf(pmax, p1[r]);
            { auto rr = __builtin_amdgcn_permlane32_swap(__float_as_uint(pmax), __float_as_uint(pmax), false, false); pmax = fmaxf(__uint_as_float(rr[0]), __uint_as_float(rr[1])); }
            float mn, alpha;
            if (__builtin_expect(__all(pmax - m_reg <= THR2), 1)) { mn = m_reg; alpha = 1.f; }
            else { mn = fmaxf(m_reg, pmax); alpha = __builtin_amdgcn_exp2f(m_reg - mn); m_reg = mn; }
            float ps = 0.f;
#pragma unroll
            for (int r = 0; r < 16; ++r) { p0[r] = __builtin_amdgcn_exp2f(p0[r] - mn); ps += p0[r]; }
#pragma unroll
            for (int r = 0; r < 16; ++r) { p1[r] = __builtin_amdgcn_exp2f(p1[r] - mn); ps += p1[r]; }
            { auto rr = __builtin_amdgcn_permlane32_swap(__float_as_uint(ps), __float_as_uint(ps), false, false); ps = __uint_as_float(rr[0]) + __uint_as_float(rr[1]); }
            l_reg = l_reg * alpha + ps;
            bf16x8 pa0, pa1, pa2, pa3;
#define PK4(P, B_, OUT) do { unsigned a0 = cvt_pk_bf16(P[B_+0], P[B_+1]), a1 = cvt_pk_bf16(P[B_+2], P[B_+3]); \
        unsigned b0 = cvt_pk_bf16(P[B_+4], P[B_+5]), b1 = cvt_pk_bf16(P[B_+6], P[B_+7]); \
        auto r0 = __builtin_amdgcn_permlane32_swap(a0, b0, false, false); auto r1 = __builtin_amdgcn_permlane32_swap(a1, b1, false, false); \
        u32x4 w = {r0[0], r1[0], r0[1], r1[1]}; OUT = __builtin_bit_cast(bf16x8, w); } while (0)
            PK4(p0, 0, pa0); PK4(p0, 8, pa1); PK4(p1, 0, pa2); PK4(p1, 8, pa3);
#undef PK4
            if (__any(alpha < 1.f)) { if (hi == 0) wsf[r32] = alpha; LDS_WAIT();
#pragma unroll
                for (int d = 0; d < 4; ++d)
#pragma unroll
                    for (int r = 0; r < 16; ++r) o[d][r] *= wsf[crow(r, hi)]; }
            const int vb0 = vrb + bf * VT;
#define TRRD(dst, off) asm volatile("ds_read_b64_tr_b16 %0, %1 offset:%2" : "=&v"(dst) : "v"(vb0), "i"(off) : "memory")
#define PV_D0(d0) do { s16x4 l0, l1, l2, l3, h0, h1, h2, h3; constexpr int b_ = v_rd_off(d0, 0, 0); \
        TRRD(l0, b_); TRRD(h0, b_ + 2048); TRRD(l1, b_ + 4096); TRRD(h1, b_ + 6144); TRRD(l2, b_ + 8192); TRRD(h2, b_ + 10240); TRRD(l3, b_ + 12288); TRRD(h3, b_ + 14336); \
        asm volatile("s_waitcnt lgkmcnt(0)" ::: "memory"); SBAR(); \
        o[d0] = __builtin_amdgcn_mfma_f32_32x32x16_bf16(pa0, (bf16x8){l0[0], l0[1], l0[2], l0[3], h0[0], h0[1], h0[2], h0[3]}, o[d0], 0, 0, 0); \
        o[d0] = __builtin_amdgcn_mfma_f32_32x32x16_bf16(pa1, (bf16x8){l1[0], l1[1], l1[2], l1[3], h1[0], h1[1], h1[2], h1[3]}, o[d0], 0, 0, 0); \
        o[d0] = __builtin_amdgcn_mfma_f32_32x32x16_bf16(pa2, (bf16x8){l2[0], l2[1], l2[2], l2[3], h2[0], h2[1], h2[2], h2[3]}, o[d0], 0, 0, 0); \
        o[d0] = __builtin_amdgcn_mfma_f32_32x32x16_bf16(pa3, (bf16x8){l3[0], l3[1], l3[2], l3[3], h3[0], h3[1], h3[2], h3[3]}, o[d0], 0, 0, 0); } while (0)
            PV_D0(0); PV_D0(1); PV_D0(2); PV_D0(3);
#undef PV_D0
#undef TRRD
        }
        LDS_WAIT(); VM_WAIT(); __builtin_amdgcn_s_barrier(); asm volatile("" ::: "memory");
    }
    if (hi == 0) wsf[32 + r32] = l_reg; LDS_WAIT();
    bf16_t* Ow = O + (tok0 + qlo) * VPITCH + h * DV;
#pragma unroll
    for (int r = 0; r < 16; ++r) { const int orow = crow(r, hi); const float rl = __builtin_amdgcn_rcpf(wsf[32 + orow]);
#pragma unroll
        for (int d = 0; d < 4; ++d) { const float v = o[d][r] * rl; const float vn = __shfl_xor(v, 1);
            if ((r32 & 1) == 0) *(unsigned*)(Ow + (size_t)orow * VPITCH + d * 32 + r32) = cvt_pk_bf16(v, vn); } }
    LDS_WAIT();
#undef ADMA
}
#undef SBAR
}

#ifndef PH_MASK
#define PH_MASK 0xFFFF
#endif
#define PH(k) (((PH_MASK) >> (k)) & 1)
constexpr int NWAVES = 8;
struct Args { const void* in[22]; float* out; unsigned char* ws; };
enum { I_X = 0, I_POS, I_NMIX, I_NFFN, I_CWIN, I_CW, I_CWOUT, I_MDOWN, I_MQAN, I_MKVAN, I_MUQ, I_MUKV, I_MQN, I_MKN, I_MWO, I_FG, I_FU, I_FD, I_MR, I_MG, I_MU, I_MD };

__device__ const double INVF[32] = {
    1.0, 0.7498942093324559, 0.5623413251903491, 0.4216965034285822, 0.31622776601683794, 0.23713737056616552, 0.1778279410038923, 0.1333521432163324,
    0.1, 0.07498942093324558, 0.05623413251903491, 0.04216965034285822, 0.03162277660168379, 0.023713737056616554, 0.01778279410038923, 0.01333521432163324,
    0.01, 0.007498942093324559, 0.005623413251903491, 0.004216965034285823, 0.0031622776601683794, 0.0023713737056616554, 0.0017782794100389228, 0.001333521432163324,
    0.001, 0.0007498942093324559, 0.0005623413251903491, 0.0004216965034285823, 0.00031622776601683794, 0.00023713737056616554, 0.00017782794100389227, 0.0001333521432163324};

template <class SrcF>
__device__ __forceinline__ void tr_item(const SrcF& src, int ld, const float* gain, int K, bf16_t* WT, LAS float* scr, int kb, int nb, int lane) {
    const int k0 = 64 * kb, n0 = 32 * nb;
    const float* colp = src(n0 + (lane & 31));
#pragma unroll 8
    for (int i = 0; i < 32; ++i) { const int kk = 2 * i + (lane >> 5); float v = colp ? colp[(size_t)(k0 + kk) * ld] : 0.f; if (gain) v *= gain[k0 + kk]; scr[kk * 33 + (lane & 31)] = v; }
    LDS_WAIT(); asm volatile("" ::: "memory");
    const int c = lane & 7;
#pragma unroll
    for (int j = 0; j < 4; ++j) { const int n = (lane >> 3) + 8 * j; const LAS float* s = scr + (8 * c) * 33 + n;
        u32x4 o; o.x = cvt_pk_bf16(s[0 * 33], s[1 * 33]); o.y = cvt_pk_bf16(s[2 * 33], s[3 * 33]); o.z = cvt_pk_bf16(s[4 * 33], s[5 * 33]); o.w = cvt_pk_bf16(s[6 * 33], s[7 * 33]);
        *(u32x4*)(WT + (size_t)(n0 + n) * K + k0 + 8 * c) = o; }
    LDS_WAIT(); asm volatile("" ::: "memory");
}

__global__ void __launch_bounds__(NWAVES * 64, 2) fwd(Args args) {
    extern __shared__ __attribute__((aligned(16))) unsigned char lds_raw[];
    LAS unsigned char* lds = (LAS unsigned char*)lds_raw;
    volatile LAS unsigned* MISC = (volatile LAS unsigned*)(lds + MISC_OFF);
    const int wave = __builtin_amdgcn_readfirstlane((int)threadIdx.x >> 6);
#define tid (wave * 64 + LANE_ID())
#define lane LANE_ID()
    const int G = gridDim.x, bx = blockIdx.x;
    const int vcu = (G % 8 == 0) ? (bx % 8) * (G / 8) + bx / 8 : bx;
    unsigned char* ws = args.ws;
    unsigned* ctl = (unsigned*)(ws + WS_CTL);
    for (int u = tid; u < (LDS_BYTES - EX_OFF) / 4; u += NWAVES * 64) ((LAS unsigned*)(lds + EX_OFF))[u] = 0u;
    __syncthreads();
    XcdBarrier bar = xcd_barrier_post(ctl + CW_BAR, MISC + 8, wave);
#define GRID_BAR() xcd_barrier(bar, wave)

    float* out = args.out; int bxl = bx; int zi = 0;
    LAS float* const EX = (LAS float*)(lds + EX_OFF);
    LAS int* const PFX = (LAS int*)(lds + TAB_OFF);
#define WSP(T_, off) ((T_*)(ws + (off)))
#define ARP(off) ((bf16_t*)(ws + WS_AR + (off)))
#define WTP(off) ((bf16_t*)(ws + WS_W + (off)))
#define INF(k) ((const float*)args.in[(k) + zi])

    for (int j = 0; j < 2; ++j) {
#define LAUNDER() do { asm volatile("" : "+s"(ws)); asm volatile("" : "+s"(out)); asm volatile("" : "+s"(bxl)); zi = 0; asm volatile("" : "+s"(zi)); } while (0)
        LAUNDER();
        if constexpr (PH(0))
        {
            int ln = LANE_ID(); asm volatile("" : "+v"(ln));
            LAS float* scr = (LAS float*)(lds + wave * 16384);
            const int gw = vcu * NWAVES + wave, NGW = G * NWAVES;
            constexpr int I_CU = 16 * 64, I_B = 16 * 32, I_OUT = 16 * 32, I_GU = 16 * 176, I_DN = 44 * 32, I_DOWN = 16 * 24, I_UQ = 6 * 64, I_UKV = 4 * 64, I_O = 16 * 32,
                          I_MGU1 = 16 * 128, I_MDN1 = 32 * 32;
            constexpr int NIT = I_CU + I_B + I_OUT + I_GU + I_DN + I_DOWN + I_UQ + I_UKV + I_O + NE * I_MGU1 + NE * I_MDN1;
            for (int it = gw; it < NIT; it += NGW) {
                int r = it;
                if (r < I_CU) { const int nblk = 64; const float* cwin = INF(I_CWIN) + (size_t)j * D * 3 * D;
                    tr_item([&](int n) { const int ch = (n >> 8) * 128 + (n & 127); return cwin + (((n >> 7) & 1) ? 2 * D + ch : D + ch); }, 3 * D, INF(I_NMIX) + (2 * j) * D, D, WTP(W_CU), scr, r / nblk, r % nblk, ln); continue; } r -= I_CU;
                if (r < I_B) { const int nblk = 32; const float* cwin = INF(I_CWIN) + (size_t)j * D * 3 * D;
                    tr_item([&](int n) { return cwin + n; }, 3 * D, INF(I_NMIX) + (2 * j) * D, D, WTP(W_B), scr, r / nblk, r % nblk, ln); continue; } r -= I_B;
                if (r < I_OUT) { const int nblk = 32; const float* cwout = INF(I_CWOUT) + (size_t)j * D * D;
                    tr_item([&](int n) { return cwout + n; }, D, nullptr, D, WTP(W_OUT), scr, r / nblk, r % nblk, ln); continue; } r -= I_OUT;
                if (r < I_GU) { const int nblk = 176; const float* fg = INF(I_FG) + (size_t)j * D * DFF; const float* fu = INF(I_FU) + (size_t)j * D * DFF;
                    tr_item([&](int n) { const int ch = (n >> 8) * 128 + (n & 127); return (((n >> 7) & 1) ? fu : fg) + ch; }, DFF, INF(I_NFFN) + (2 * j) * D, D, WTP(W_GU), scr, r / nblk, r % nblk, ln); continue; } r -= I_GU;
                if (r < I_DN) { const int nblk = 32; const float* fd = INF(I_FD) + (size_t)j * DFF * D;
                    tr_item([&](int n) { return fd + n; }, D, nullptr, DFF, WTP(W_DN), scr, r / nblk, r % nblk, ln); continue; } r -= I_DN;
                if (r < I_DOWN) { const int nblk = 24; const float* mdown = INF(I_MDOWN) + (size_t)j * D * 704;
                    tr_item([&](int n) { return n < 704 ? mdown + n : (const float*)nullptr; }, 704, INF(I_NMIX) + (2 * j + 1) * D, D, WTP(W_DOWN), scr, r / nblk, r % nblk, ln); continue; } r -= I_DOWN;
                if (r < I_UQ) { const int nblk = 64; const float* muq = INF(I_MUQ) + (size_t)j * 384 * 1536;
                    tr_item([&](int n) { const int hh = n >> 8, c = n & 255;
                        if (c < 128) return muq + hh * DQK + c;
                        if (c < 192) { const int cc = c - 128, g = cc >> 5, rr = cc & 31, q = rr >> 3, nn = (rr >> 2) & 1, jj = rr & 3, i = g * 16 + q * 4 + jj; return muq + hh * DQK + 128 + nn * 32 + i; }
                        return (const float*)nullptr; }, 1536, INF(I_MQAN) + j * 384, 384, WTP(W_UQ), scr, r / nblk, r % nblk, ln); continue; } r -= I_UQ;
                if (r < I_UKV) { const int nblk = 64; const float* mukv = INF(I_MUKV) + (size_t)j * 256 * 2048;
                    tr_item([&](int n) { return mukv + n; }, 2048, INF(I_MKVAN) + j * 256, 256, WTP(W_UKV), scr, r / nblk, r % nblk, ln); continue; } r -= I_UKV;
                if (r < I_O) { const int nblk = 32; const float* mwo = INF(I_MWO) + (size_t)j * D * D;
                    tr_item([&](int n) { return mwo + n; }, D, nullptr, D, WTP(W_O), scr, r / nblk, r % nblk, ln); continue; } r -= I_O;
                if (r < NE * I_MGU1) { const int e = r / I_MGU1, rr = r % I_MGU1, nblk = 128; const float* g_ = INF(I_MG) + ((size_t)j * NE + e) * D * DFE; const float* u_ = INF(I_MU) + ((size_t)j * NE + e) * D * DFE;
                    tr_item([&](int n) { const int ch = (n >> 8) * 128 + (n & 127); return (((n >> 7) & 1) ? u_ : g_) + ch; }, DFE, INF(I_NFFN) + (2 * j + 1) * D, D, WTP(W_MGU) + (size_t)e * 4096 * D, scr, rr / nblk, rr % nblk, ln); continue; } r -= NE * I_MGU1;
                { const int e = r / I_MDN1, rr = r % I_MDN1, nblk = 32; const float* d_ = INF(I_MD) + ((size_t)j * NE + e) * DFE * D;
                    tr_item([&](int n) { return d_ + n; }, D, nullptr, DFE, WTP(W_MDN) + (size_t)e * D * DFE, scr, rr / nblk, rr % nblk, ln); }
            }
            if (j == 0) {
                const int* pos = (const int*)INF(I_POS); const float* x_in = INF(I_X);
                bf16_t* XB = WSP(bf16_t, WS_XB); float* SSQ = WSP(float, WS_SSQ); float* COS = WSP(float, WS_COS); float* SIN = WSP(float, WS_SIN);
                for (int m = gw; m < T; m += NGW) {
                    const f32x4* xr = (const f32x4*)(x_in + (size_t)m * D) + ln;
                    f32x4 v[4]; float s = 0.f;
#pragma unroll
                    for (int q = 0; q < 4; ++q) { v[q] = xr[64 * q]; s += dot4(v[q]); }
                    s = wave_sum(s);
                    u32x2* o8 = (u32x2*)(XB + (size_t)m * D) + ln;
#pragma unroll
                    for (int q = 0; q < 4; ++q) { u32x2 w; w.x = cvt_pk_bf16(v[q][0], v[q][1]); w.y = cvt_pk_bf16(v[q][2], v[q][3]); o8[64 * q] = w; }
                    if (ln < 4) SSQ[(size_t)m * 4 + ln] = ln == 0 ? s : 0.f;
                    if (ln < 32) {
                        const double a = (double)pos[m] * INVF[ln];
                        const double n = __builtin_rint(a * 0.15915494309189535);
                        const float rr = (float)(a - n * 6.283185307179586);
                        COS[(size_t)m * 32 + ln] = cosf(rr); SIN[(size_t)m * 32 + ln] = sinf(rr);
                    }
                }
            }
        }
        GRID_BAR();
        LAUNDER();
        if constexpr (PH(1))
        {
            pg::SchedPlain S{WSP(bf16_t, WS_XB), D, WTP(W_CU), D, T / 256, 8, G, bxl};
            pg::EpiCU E{WSP(float, WS_SSQ), ARP(AR_V)};
            pg::gemm_phase(lds, D, S, E, wave);
        }
        GRID_BAR();
        LAUNDER();
        if constexpr (PH(2))
        {
            pg::SchedPlain S{WSP(bf16_t, WS_XB), D, WTP(W_B), D, T / 256, 4, G, bxl};
            pg::EpiB E{WSP(float, WS_SSQ), ARP(AR_V), INF(I_CW) + (size_t)j * 3 * D, ARP(AR_G)};
            pg::gemm_phase(lds, D, S, E, wave);
        }
        GRID_BAR();
        LAUNDER();
        if constexpr (PH(3))
        {
            pg::SchedPlain S{ARP(AR_G), D, WTP(W_OUT), D, T / 256, 4, G, bxl};
            pg::EpiRes E{j == 0 ? INF(I_X) : (const float*)out, out, WSP(bf16_t, WS_XB), WSP(float, WS_SSQ), EX};
            pg::gemm_phase(lds, D, S, E, wave);
        }
        GRID_BAR();
        LAUNDER();
        if constexpr (PH(4))
        {
            pg::SchedPlain S{WSP(bf16_t, WS_XB), D, WTP(W_GU), D, T / 256, 22, G, bxl};
            pg::EpiGU<false> E{WSP(float, WS_SSQ), ARP(AR_ACT), DFF, nullptr};
            pg::gemm_phase(lds, D, S, E, wave);
        }
        GRID_BAR();
        LAUNDER();
        if constexpr (PH(5))
        {
            pg::SchedPlain S{ARP(AR_ACT), DFF, WTP(W_DN), DFF, T / 256, 4, G, bxl};
            pg::EpiRes E{out, out, WSP(bf16_t, WS_XB), WSP(float, WS_SSQ), EX};
            pg::gemm_phase(lds, DFF, S, E, wave);
        }
        GRID_BAR();
        LAUNDER();
        if constexpr (PH(6))
        {
            pg::SchedPlain S{WSP(bf16_t, WS_XB), D, WTP(W_DOWN), D, T / 256, 3, G, bxl};
            pg::EpiDown E{WSP(float, WS_SSQ), ARP(AR_DOWN), WSP(float, WS_KROPE), WSP(float, WS_MSSQ), EX};
            pg::gemm_phase(lds, D, S, E, wave);
        }
        GRID_BAR();
        LAUNDER();
        if constexpr (PH(7))
        {
            pg::SchedPlain S{ARP(AR_DOWN), DOWNP, WTP(W_UQ), 384, T / 256, 8, G, bxl};
            pg::EpiQ E{WSP(float, WS_MSSQ), INF(I_MQN) + j * DQK, WSP(float, WS_COS), WSP(float, WS_SIN), ARP(AR_Q), EX};
            pg::gemm_phase(lds, 384, S, E, wave);
        }
        LAUNDER();
        if constexpr (PH(8))
        {
            pg::SchedPlain S{ARP(AR_DOWN) + 384, DOWNP, WTP(W_UKV), 256, T / 256, 8, G, bxl};
            pg::EpiKV E{WSP(float, WS_MSSQ), WSP(float, WS_KROPE), INF(I_MKN) + j * DQK, WSP(float, WS_COS), WSP(float, WS_SIN), ARP(AR_K), ARP(AR_VV), EX};
            pg::gemm_phase(lds, 256, S, E, wave);
        }
        GRID_BAR();
        LAUNDER();
        if constexpr (PH(9))
        {
            const bf16_t* Qp = ARP(AR_Q); const bf16_t* Kp = ARP(AR_K); const bf16_t* Vp = ARP(AR_VV); bf16_t* Op = ARP(AR_O);
            for (int it = vcu; it < NBATCH * NH * 4; it += G) {
                const int bh = it >> 2, pr = it & 3, b = bh >> 3, h = bh & 7;
                for (int pass = 0; pass < 2; ++pass) att::attn_unit(Qp, Kp, Vp, Op, b, h, pass == 0 ? 7 - pr : pr, lds, wave);
            }
        }
        GRID_BAR();
        LAUNDER();
        if constexpr (PH(10))
        {
            pg::SchedPlain S{ARP(AR_O), D, WTP(W_O), D, T / 256, 4, G, bxl};
            pg::EpiRes E{out, out, WSP(bf16_t, WS_XB), WSP(float, WS_SSQ), EX};
            pg::gemm_phase(lds, D, S, E, wave);
        }
        GRID_BAR();
        LAUNDER();
        if constexpr (PH(11))
        {
            int tl = wave * 64 + LANE_ID(); asm volatile("" : "+v"(tl)); const int ln = tl & 63;
            LAS float* GR = (LAS float*)lds;
            LAS int* LC = (LAS int*)(lds + 32768);
            int* ME = WSP(int, WS_ME); float* MW = WSP(float, WS_MW); int* WGCNT = WSP(int, WS_WGCNT);
            const float* nffn1 = INF(I_NFFN) + (2 * j + 1) * D; const float* rt = INF(I_MR) + (size_t)j * D * NE;
            for (int i = tl; i < D * NE; i += NWAVES * 64) { const int k = i >> 3, e = i & 7; GR[e * D + k] = nffn1[k] * rt[i]; }
            for (int ch = bx; ch < T / 128; ch += G) {
                if (tl < 16) LC[tl] = 0;
                __syncthreads();
                for (int q = 0; q < 16; ++q) {
                    const int tk = ch * 128 + wave * 16 + q;
                    const f32x4* xr = (const f32x4*)(out + (size_t)tk * D) + ln;
                    f32x4 v[4]; float s = 0.f, lg[8];
#pragma unroll
                    for (int qq = 0; qq < 4; ++qq) { v[qq] = xr[64 * qq]; s += dot4(v[qq]); }
#pragma unroll
                    for (int e = 0; e < 8; ++e) { float a = 0.f;
#pragma unroll
                        for (int qq = 0; qq < 4; ++qq) { const f32x4 g = *(const LAS f32x4*)(GR + e * D + 4 * ln + 256 * qq); a += (v[qq][0] * g[0] + v[qq][1] * g[1]) + (v[qq][2] * g[2] + v[qq][3] * g[3]); }
                        lg[e] = wave_sum(a); }
                    s = wave_sum(s);
                    const float rs = rsq(s * (1.0f / D) + EPS);
                    int e1 = 0; float l1 = lg[0];
#pragma unroll
                    for (int e = 1; e < 8; ++e) if (lg[e] > l1) { l1 = lg[e]; e1 = e; }
                    int e2 = 0; float l2 = -__builtin_inff();
#pragma unroll
                    for (int e = 0; e < 8; ++e) if (e != e1 && lg[e] > l2) { l2 = lg[e]; e2 = e; }
                    const float ex = __expf((l2 - l1) * rs), w1 = 1.0f / (1.0f + ex), w2 = ex / (1.0f + ex);
                    if (ln == 0) {
                        const int r1 = atomicAdd((int*)&LC[e1], 1), r2 = atomicAdd((int*)&LC[8 + e2], 1);
                        ME[tk] = e1 | (e2 << 4) | (r1 << 8) | (r2 << 16); MW[2 * tk] = w1; MW[2 * tk + 1] = w2;
                    }
                }
                __syncthreads();
                if (tl < 16) WGCNT[ch * 16 + tl] = LC[tl];
                __syncthreads();
            }
        }
        GRID_BAR();
        LAUNDER();
        if constexpr (PH(12))
        {
            int tl = wave * 64 + LANE_ID(); asm volatile("" : "+v"(tl));
            LAS int* PART = (LAS int*)lds;
            LAS int* BASE = (LAS int*)(lds + 4096);
            LAS int* OFFS = (LAS int*)(lds + 4096 + 64);
            int* ME = WSP(int, WS_ME); float* MW = WSP(float, WS_MW); int* WGCNT = WSP(int, WS_WGCNT); int* TOK = WSP(int, WS_TOK); float* WSL = WSP(float, WS_WSL); int* TAB = WSP(int, WS_TAB);
            { const int l = tl & 15, part = tl >> 4; int s = 0;
              for (int c = 0; c < 8; ++c) s += WGCNT[(part * 8 + c) * 16 + l];
              PART[part * 16 + l] = s; }
            __syncthreads();
            if (tl < 16) { int run = 0; for (int p = 0; p < 32; ++p) { const int v = PART[p * 16 + tl]; PART[p * 16 + tl] = run; run += v; } OFFS[tl] = run; }
            __syncthreads();
            if (tl == 0) { int tp = 0; for (int l = 0; l < 16; ++l) { BASE[l] = tp * 256; PFX[l] = tp; tp += (OFFS[l] + 255) >> 8; } PFX[16] = tp;
                if (bx == 0) { for (int l = 0; l <= 16; ++l) TAB[l] = PFX[l]; } }
            __syncthreads();
            if (bx < 16) { const int l = bx, tot = OFFS[l], b0 = BASE[l], e0 = b0 + (((tot + 255) >> 8) << 8);
                for (int s = b0 + tot + tl; s < e0; s += NWAVES * 64) { TOK[s] = -1; WSL[s] = 0.f; } }
            __syncthreads();
            for (int ch = bx; ch < T / 128; ch += G) {
                if (tl < 16) { int o = BASE[tl] + PART[(ch >> 3) * 16 + tl]; for (int c = (ch & ~7); c < ch; ++c) o += WGCNT[c * 16 + tl]; OFFS[tl] = o; }
                __syncthreads();
                if (tl < 128) { const int tk = ch * 128 + tl, me = ME[tk]; const int e1 = me & 15, e2 = (me >> 4) & 15, r1 = (me >> 8) & 255, r2 = (me >> 16) & 255;
                    const int s1 = OFFS[e1] + r1, s2 = OFFS[8 + e2] + r2;
                    TOK[s1] = tk; WSL[s1] = MW[2 * tk]; TOK[s2] = tk; WSL[s2] = MW[2 * tk + 1]; }
                __syncthreads();
            }
        }
        GRID_BAR();
        if (tid <= 16) PFX[tid] = WSP(int, WS_TAB)[tid];
        __syncthreads();
        LAUNDER();
        if constexpr (PH(13))
        {
            pg::SchedMoeGU S{WSP(bf16_t, WS_XB), WSP(int, WS_TOK), WTP(W_MGU), PFX, PFX[16], G, bxl};
            pg::EpiGU<true> E{WSP(float, WS_SSQ), ARP(AR_ACT), DFE, WSP(int, WS_TOK)};
            pg::gemm_phase(lds, D, S, E, wave);
        }
        GRID_BAR();
        LAUNDER();
        if constexpr (PH(14))
        {
            pg::SchedMoeDn S{ARP(AR_ACT), WTP(W_MDN), PFX, 0, PFX[8], G, bxl};
            pg::EpiMoeDn E{WSP(int, WS_TOK), WSP(float, WS_WSL), out, nullptr, nullptr, EX};
            pg::gemm_phase(lds, DFE, S, E, wave);
        }
        GRID_BAR();
        LAUNDER();
        if constexpr (PH(15))
        {
            pg::SchedMoeDn S{ARP(AR_ACT), WTP(W_MDN), PFX, PFX[8], PFX[16] - PFX[8], G, bxl};
            pg::EpiMoeDn E{WSP(int, WS_TOK), WSP(float, WS_WSL), out, j == 0 ? WSP(bf16_t, WS_XB) : nullptr, WSP(float, WS_SSQ), EX};
            pg::gemm_phase(lds, DFE, S, E, wave);
        }
        if (j == 0) GRID_BAR();
    }
}

#undef tid
#undef lane
extern "C" void kernel_launch(void* const* d_in, const int* in_sizes, int n_in, void* d_out, int out_size, void* d_ws, size_t ws_size, hipStream_t stream) {
    static int grid = 0;
    if (grid == 0) {
        if (n_in != 22 || out_size != T * D || ws_size < WS_END) { fprintf(stderr, "kernel_launch: unexpected shapes (n_in %d, out %d, ws %zu)\n", n_in, out_size, ws_size); grid = -1; return; }
        int dev = 0, cus = 0;
        if (hipGetDevice(&dev) != hipSuccess || hipDeviceGetAttribute(&cus, hipDeviceAttributeMultiprocessorCount, dev) != hipSuccess) { grid = -1; return; }
        if (hipFuncSetAttribute((const void*)fwd, hipFuncAttributeMaxDynamicSharedMemorySize, LDS_BYTES) != hipSuccess) { fprintf(stderr, "kernel_launch: hipFuncSetAttribute failed\n"); grid = -1; return; }
        int per_cu = 0;
        if (hipOccupancyMaxActiveBlocksPerMultiprocessor(&per_cu, (const void*)fwd, NWAVES * 64, LDS_BYTES) != hipSuccess || per_cu < 1) fprintf(stderr, "kernel_launch: occupancy query says %d\n", per_cu);
        (void)hipGetLastError();
        grid = cus;
    }
    if (grid < 0) return;
    (void)hipMemsetAsync((char*)d_ws + WS_CTL, 0, CTL_ZERO_BYTES, stream);
    Args a{};
    for (int i = 0; i < 22; ++i) a.in[i] = d_in[i];
    a.out = (float*)d_out; a.ws = (unsigned char*)d_ws;
    hipLaunchKernelGGL(fwd, dim3(grid), dim3(NWAVES * 64), LDS_BYTES, stream, a);
}
```

```cpp
#include <hip/hip_runtime.h>
#include <cstdio>
#include <cstdint>

#define LAS __attribute__((address_space(3)))
#define GAS __attribute__((address_space(1)))
typedef unsigned short bf16_t;
typedef short bf16x8 __attribute__((ext_vector_type(8)));
typedef short s16x4 __attribute__((ext_vector_type(4)));
typedef float f32x2 __attribute__((ext_vector_type(2)));
typedef float f32x4 __attribute__((ext_vector_type(4)));
typedef float f32x16 __attribute__((ext_vector_type(16)));
typedef unsigned u32x2 __attribute__((ext_vector_type(2)));
typedef unsigned u32x4 __attribute__((ext_vector_type(4)));
typedef GAS unsigned gu32;

constexpr int T = 32768, D = 1024, SEQ = 2048, NBATCH = 16, NH = 8;
constexpr int DQK = 192, DV = 128, QPITCH = NH * DQK  , VPITCH = NH * DV  ;
constexpr int DFF = 2816, DFE = 2048, NE = 8;
constexpr int DOWNP = 768;
constexpr float EPS = 1e-6f;
constexpr float QSCALE = 0.07216878364870322f * 1.4426950408889634f;
constexpr int MAXSLOT = 65536 + 16 * 256;

constexpr size_t MiB = 1u << 20;
constexpr size_t WS_CTL = 0, CTL_ZERO_BYTES = 1 * MiB;
constexpr size_t WS_SSQ = 1 * MiB;
constexpr size_t WS_MSSQ = 3 * MiB;
constexpr size_t WS_KROPE = 6 * MiB;
constexpr size_t WS_COS = 14 * MiB, WS_SIN = 18 * MiB;
constexpr size_t WS_ME = 22 * MiB;
constexpr size_t WS_MW = 22 * MiB + 256 * 1024;
constexpr size_t WS_WGCNT = 23 * MiB;
constexpr size_t WS_TAB = 23 * MiB + 64 * 1024;
constexpr size_t WS_TOK = 24 * MiB;
constexpr size_t WS_WSL = 24 * MiB + 512 * 1024;
constexpr size_t WS_XB = 26 * MiB;
constexpr size_t WS_W = 90 * MiB;
constexpr size_t W_CU = 0, W_B = 4 * MiB, W_OUT = 6 * MiB, W_GU = 8 * MiB, W_DN = 19 * MiB, W_DOWN = 25 * MiB, W_UQ = 26 * MiB + 512 * 1024,
                 W_UKV = 28 * MiB, W_O = 29 * MiB, W_MGU = 32 * MiB, W_MDN = 96 * MiB;
constexpr size_t WS_AR = 218 * MiB;
constexpr size_t AR_V = 0, AR_G = 64 * MiB;
constexpr size_t AR_ACT = 0;
constexpr size_t AR_DOWN = 0, AR_Q = 64 * MiB, AR_K = 160 * MiB, AR_VV = 256 * MiB, AR_O = 0;
constexpr size_t WS_END = 538 * MiB;

constexpr int CW_BAR = 4096;

constexpr int RING_BYTES = 131072;
constexpr int EX_OFF = RING_BYTES;
constexpr int TAB_OFF = EX_OFF + 8192;
constexpr int MISC_OFF = TAB_OFF + 256;
constexpr int LDS_BYTES = MISC_OFF + 128 + 1024;

__device__ __forceinline__ unsigned cvt_pk_bf16(float lo, float hi) { unsigned r; asm volatile("v_cvt_pk_bf16_f32 %0, %1, %2" : "=v"(r) : "v"(lo), "v"(hi)); return r; }
__device__ __forceinline__ u32x4 pack8(f32x4 a, f32x4 b) { u32x4 w; w.x = cvt_pk_bf16(a[0], a[1]); w.y = cvt_pk_bf16(a[2], a[3]); w.z = cvt_pk_bf16(b[0], b[1]); w.w = cvt_pk_bf16(b[2], b[3]); return w; }
__device__ __forceinline__ float sum4(f32x4 a) { return (a[0] + a[1]) + (a[2] + a[3]); }
__device__ __forceinline__ float dot4(f32x4 a) { return (a[0] * a[0] + a[1] * a[1]) + (a[2] * a[2] + a[3] * a[3]); }
__device__ __forceinline__ float rsq(float x) { return 1.0f / __builtin_sqrtf(x); }
__device__ __forceinline__ float bf2f(unsigned short u) { return __builtin_bit_cast(float, (unsigned)u << 16); }
__device__ __forceinline__ float wave_sum(float v) {
#pragma unroll
    for (int o = 1; o < 64; o <<= 1) v += __shfl_xor(v, o);
    return v;
}
__device__ __forceinline__ int lane_id_now() { int l; asm volatile("v_mbcnt_lo_u32_b32 %0, -1, 0\n\tv_mbcnt_hi_u32_b32 %0, -1, %0" : "=v"(l)); return l; }
#define LANE_ID() lane_id_now()
#define LDS_WAIT() asm volatile("s_waitcnt lgkmcnt(0)" ::: "memory")
#define VM_WAIT() asm volatile("s_waitcnt vmcnt(0)" ::: "memory")

#define XB_TMO      128
#define XB_XCNT(j)  (256  + 64 * (j))
#define XB_XSUB(j)  (1280 + 64 * (j))
#define XB_XGEN(j)  (2304 + 64 * (j))
#define XB_TOP      3328
#define XB_TOPGEN   3392
#define XCD_BAR_WORDS 3456
#define XB_SPIN_CAP (1u << 18)

__device__ __forceinline__ unsigned xb_ld(unsigned* p)              { return __hip_atomic_load(p, __ATOMIC_RELAXED, __HIP_MEMORY_SCOPE_AGENT); }
__device__ __forceinline__ unsigned xb_add(unsigned* p, unsigned v) { return __hip_atomic_fetch_add(p, v, __ATOMIC_RELAXED, __HIP_MEMORY_SCOPE_AGENT); }
__device__ __forceinline__ unsigned xb_xcc_id() { return (unsigned)__builtin_amdgcn_s_getreg((3 << 11) | 20) & 0xFu; }
#define XB_SPIN(cond, bar) do { unsigned _sp = 0; while (cond) { __builtin_amdgcn_s_sleep(1); \
    if ((++_sp & 255u) == 0u) { if (xb_ld(&(bar)[XB_TMO])) break; if (_sp > XB_SPIN_CAP) { atomicAdd(&(bar)[XB_TMO], 1u); break; } } } } while (0)

struct XcdBarrier { unsigned* bar; unsigned x; volatile LAS unsigned* st; };

__device__ __forceinline__ XcdBarrier xcd_barrier_post(unsigned* bar, volatile LAS unsigned* st, const int wave) {
    XcdBarrier b; b.bar = bar; b.x = xb_xcc_id(); b.st = st;
    if (wave == 0 && LANE_ID() == 0) (void)xb_add(&bar[XB_XCNT(b.x)], 1u);
    return b;
}
__device__ __forceinline__ void xcd_barrier_complete(unsigned* bar, unsigned x, unsigned& nloc, unsigned& nx) {
    const unsigned G = gridDim.x * gridDim.y * gridDim.z;
    unsigned sum, cnt, mine, sp = 0u;
    for (;;) {
        sum = 0u; cnt = 0u; mine = 0u;
#pragma unroll
        for (unsigned j = 0; j < 16; ++j) { const unsigned c = xb_ld(&bar[XB_XCNT(j)]); sum += c; cnt += (c > 0u) ? 1u : 0u; mine = (j == x) ? c : mine; }
        if (sum == G) break;
        __builtin_amdgcn_s_sleep(1);
        if ((++sp & 255u) == 0u) { if (xb_ld(&bar[XB_TMO])) break; if (sp > XB_SPIN_CAP) { atomicAdd(&bar[XB_TMO], 1u); break; } }
    }
    nloc = mine > 0u ? mine : 1u; nx = cnt > 0u ? cnt : 1u;
}
__device__ __forceinline__ void xcd_barrier(const XcdBarrier& b, const int wave) {
    asm volatile("s_waitcnt vmcnt(0)" ::: "memory");
    __syncthreads();
    if (wave == 0 && LANE_ID() == 0) {
        unsigned* bar = b.bar;
        __builtin_amdgcn_s_waitcnt(0);
        unsigned nloc = b.st[0], nx = b.st[1];
        if (nloc == 0u) { xcd_barrier_complete(bar, b.x, nloc, nx); b.st[0] = nloc; b.st[1] = nx; }
        const unsigned old = xb_add(&bar[XB_XSUB(b.x)], 1u);
        const unsigned gen = old / nloc;
        if (old + 1u == (gen + 1u) * nloc) {
            __builtin_amdgcn_fence(__ATOMIC_RELEASE, "agent");
            asm volatile("s_waitcnt vmcnt(0)" ::: "memory");
            const unsigned og = xb_add(&bar[XB_TOP], 1u);
            const unsigned tg = og / nx;
            if (og + 1u == (tg + 1u) * nx) xb_add(&bar[XB_TOPGEN], 1u);
            else XB_SPIN(xb_ld(&bar[XB_TOPGEN]) == tg, bar);
            __builtin_amdgcn_fence(__ATOMIC_ACQUIRE, "agent");
            xb_add(&bar[XB_XGEN(b.x)], 1u);
            asm volatile("s_waitcnt vmcnt(0)" ::: "memory");
        } else {
            XB_SPIN(xb_ld(&bar[XB_XGEN(b.x)]) == gen, bar);
            __builtin_amdgcn_fence(__ATOMIC_ACQUIRE, "agent");
            asm volatile("s_waitcnt vmcnt(0)" ::: "memory");
        }
    }
    __syncthreads();
}

namespace pg {
constexpr int BM = 256, BK = 64, HALF = 128, HTB = HALF * BK * 2, STAGE_BYTES = 8 * HTB;
__host__ __device__ __forceinline__ int lds_byte(int r, int c) { const int st = (r >> 4) * 2 + (c >> 5), rr = r & 15, cc = c & 31, ob = rr * 64 + cc * 2; return st * 1024 + (ob ^ (((ob >> 9) & 1) << 5)); }
__host__ __device__ __forceinline__ void stage_rc(int b, int& R, int& C) { const int st = b / 1024, sb = b % 1024, swz = sb ^ (((sb >> 9) & 1) << 5); R = (st >> 1) * 16 + swz / 64; C = (st & 1) * 32 + (swz % 64) / 2; }
__host__ __device__ __forceinline__ int perm32(int rho) { const int n = rho >> 4, i = rho & 15; return 8 * (i >> 2) + 4 * n + (i & 3); }

struct Unit { int pm, pn, e; };

__device__ __forceinline__ bool unit_of(long L, int nM, int nN, int& pm, int& pn) {
    const int nwg = nM * nN; if (L >= nwg) return false;
    int wgid = (int)L; { const int q = nwg / 8, r = nwg % 8, xcd = wgid % 8, off = wgid / 8; wgid = (xcd < r ? xcd * (q + 1) : r * (q + 1) + (xcd - r) * q) + off; }
    const int nig = 8 * nN, gid = wgid / nig, fm = gid * 8, gsz = (nM - fm) < 8 ? (nM - fm) : 8;
    pm = fm + ((wgid % nig) % gsz); pn = (wgid % nig) / gsz; return true;
}

struct SchedPlain {
    const bf16_t* A; int lda; const bf16_t* Bt; int K; int nM, nN, G, c;
    static constexpr bool GATHER = false;
    __device__ __forceinline__ bool next(int i, Unit& u) const { u.e = 0; return unit_of((long)i * G + c, nM, nN, u.pm, u.pn); }
    __device__ __forceinline__ void addrA(const Unit& u, const int (&R)[2], const int (&C)[2], const char*& base, unsigned (&v)[2][2]) const {
        base = (const char*)(A + (size_t)u.pm * BM * lda);
#pragma unroll
        for (int h = 0; h < 2; ++h)
#pragma unroll
            for (int i = 0; i < 2; ++i) v[h][i] = (unsigned)((h * HALF + R[i]) * lda + C[i]) * 2u;
    }
    __device__ __forceinline__ const char* ptrB(const Unit& u) const { return (const char*)(Bt + (size_t)u.pn * BM * K); }
};
struct SchedMoeGU {
    const bf16_t* A; const int* tok; const bf16_t* Bt; const LAS int* pfx; int nM, G, c;
    static constexpr bool GATHER = true;
    __device__ __forceinline__ int list_of(int mt) const { int l = 0;
#pragma unroll
        for (int k = 1; k < 16; ++k) l += (mt >= pfx[k]) ? 1 : 0;
        return l; }
    __device__ __forceinline__ bool next(int i, Unit& u) const { if (!unit_of((long)i * G + c, nM, 16, u.pm, u.pn)) return false; u.e = list_of(u.pm) & 7; return true; }
    __device__ __forceinline__ void addrA(const Unit& u, const int (&R)[2], const int (&C)[2], const char*& base, unsigned (&v)[2][2]) const {
        base = (const char*)A;
#pragma unroll
        for (int h = 0; h < 2; ++h)
#pragma unroll
            for (int i = 0; i < 2; ++i) { int t = tok[u.pm * BM + h * HALF + R[i]]; t = t < 0 ? 0 : t; v[h][i] = (unsigned)(t * D + C[i]) * 2u; }
    }
    __device__ __forceinline__ const char* ptrB(const Unit& u) const { return (const char*)(Bt + ((size_t)u.e * 4096 + (size_t)u.pn * BM) * D); }
};
struct SchedMoeDn {
    const bf16_t* A; const bf16_t* Bt; const LAS int* pfx; int lo, nM, G, c;
    static constexpr bool GATHER = false;
    __device__ __forceinline__ int list_of(int mt) const { int l = 0;
#pragma unroll
        for (int k = 1; k < 16; ++k) l += (mt >= pfx[k]) ? 1 : 0;
        return l; }
    __device__ __forceinline__ bool next(int i, Unit& u) const { if (!unit_of((long)i * G + c, nM, 4, u.pm, u.pn)) return false; u.pm += lo; u.e = list_of(u.pm) & 7; return true; }
    __device__ __forceinline__ void addrA(const Unit& u, const int (&R)[2], const int (&C)[2], const char*& base, unsigned (&v)[2][2]) const {
        base = (const char*)(A + (size_t)u.pm * BM * DFE);
#pragma unroll
        for (int h = 0; h < 2; ++h)
#pragma unroll
            for (int i = 0; i < 2; ++i) v[h][i] = (unsigned)((h * HALF + R[i]) * DFE + C[i]) * 2u;
    }
    __device__ __forceinline__ const char* ptrB(const Unit& u) const { return (const char*)(Bt + ((size_t)u.e * 1024 + (size_t)u.pn * BM) * DFE); }
};

template <class Epi, class Sched>
__device__ __forceinline__ void gemm_phase(LAS unsigned char* lds, const int K, const Sched& S, const Epi& E, const int wave) {
    int tid = wave * 64 + LANE_ID(); asm volatile("" : "+v"(tid));
    const int wid = wave, lane = tid & 63, wr = wid >> 2, wc = wid & 3, fr = lane & 15, fq = lane >> 4;
    int nt = K / BK; asm volatile("" : "+s"(nt));
    int R[2], C[2]; unsigned voffB[2];
#pragma unroll
    for (int i = 0; i < 2; ++i) { stage_rc(tid * 16 + i * 8192, R[i], C[i]); const int Rb = (R[i] & ~31) + perm32(R[i] & 31); voffB[i] = (unsigned)(Rb * K + C[i]) * 2u; }
    const size_t kstep = (size_t)(BK * 2);
    const size_t hstepB = (size_t)HALF * K * 2;
    const unsigned ldsw = (unsigned)wid * 1024u;
    const int aoff = lds_byte(wr * 64 + fr, fq * 8), boff = lds_byte(wc * 32 + fr, fq * 8);
#define PG_SA(b, h) (((b) * 2 + (h)) * HTB)
#define PG_SB(b, h) ((4 + (b) * 2 + (h)) * HTB)
#define PG_STAGE(bufoff, gbase, voff) do { _Pragma("unroll") for (int _i = 0; _i < 2; ++_i) \
        __builtin_amdgcn_global_load_lds((const unsigned*)((const char*)(gbase) + (voff)[_i]), (LAS unsigned*)(lds + (bufoff) + ldsw + _i * 8192), 16, 0, 0); } while (0)
#define PG_LDA(dst, b, h) do { _Pragma("unroll") for (int m = 0; m < 4; ++m) _Pragma("unroll") for (int k = 0; k < 2; ++k) dst[m][k] = *(const LAS bf16x8*)(lds + PG_SA(b, h) + aoff + m * 2048 + k * 1024); } while (0)
#define PG_LDB(dst, b, h) do { _Pragma("unroll") for (int n = 0; n < 2; ++n) _Pragma("unroll") for (int k = 0; k < 2; ++k) dst[n][k] = *(const LAS bf16x8*)(lds + PG_SB(b, h) + boff + n * 2048 + k * 1024); } while (0)
#define PG_MMA(ai, bj, At, Bt) do { __builtin_amdgcn_s_setprio(1); _Pragma("unroll") for (int m = 0; m < 4; ++m) _Pragma("unroll") for (int n = 0; n < 2; ++n) _Pragma("unroll") for (int k = 0; k < 2; ++k) \
        acc[ai][bj][m][n] = __builtin_amdgcn_mfma_f32_16x16x32_bf16(Bt[n][k], At[m][k], acc[ai][bj][m][n], 0, 0, 0); __builtin_amdgcn_s_setprio(0); } while (0)
#define PG_WAIT_V(n) asm volatile("s_waitcnt vmcnt(" #n ")" ::: "memory")
#define PG_WAIT_L(n) asm volatile("s_waitcnt lgkmcnt(" #n ")" ::: "memory")
#define PG_BAR __builtin_amdgcn_s_barrier()
#define PG_SCHED __builtin_amdgcn_sched_barrier(0)
    Unit cur, nxt; int ui = 0;
    if (!S.next(0, cur)) return;
    f32x4 acc[2][2][4][2];
#pragma unroll
    for (int a = 0; a < 2; ++a)
#pragma unroll
        for (int b = 0; b < 2; ++b)
#pragma unroll
            for (int m = 0; m < 4; ++m)
#pragma unroll
                for (int n = 0; n < 2; ++n) acc[a][b][m][n] = (f32x4){0.f, 0.f, 0.f, 0.f};
    bf16x8 At[4][2], B0[2][2], B1[2][2];
    unsigned vA[2][2], vN[2][2];
    const char* cA; S.addrA(cur, R, C, cA, vA);
    const char* cB = S.ptrB(cur);
    PG_STAGE(PG_SB(0, 0), cB, voffB); PG_STAGE(PG_SB(0, 1), cB + hstepB, voffB); PG_STAGE(PG_SA(0, 0), cA, vA[0]); PG_STAGE(PG_SA(0, 1), cA, vA[1]);
    if (wr == 1) PG_BAR;
    PG_WAIT_V(2); PG_BAR;
    PG_STAGE(PG_SB(1, 0), cB + kstep, voffB); PG_STAGE(PG_SA(1, 0), cA + kstep, vA[0]); PG_STAGE(PG_SB(1, 1), cB + hstepB + kstep, voffB);
    PG_WAIT_V(6); PG_BAR;
    for (;;) {
        const bool has_next = S.next(ui + 1, nxt);
        const char* nA = cA; const char* nB = cB;
#pragma unroll
        for (int h = 0; h < 2; ++h)
#pragma unroll
            for (int i = 0; i < 2; ++i) vN[h][i] = vA[h][i];
        if (has_next) { S.addrA(nxt, R, C, nA, vN); nB = S.ptrB(nxt); }
        for (int t = 0; t < nt; t += 2) {
            const bool last = (t == nt - 2);
            const char* a1 = cA + (size_t)(t + 1) * kstep;
            const char* a2 = last ? nA : cA + (size_t)(t + 2) * kstep; const char* b2 = last ? nB : cB + (size_t)(t + 2) * kstep;
            const char* a3 = a2 + kstep; const char* b3 = b2 + kstep;
            unsigned w0[2], w1[2];
            if constexpr (Sched::GATHER) { w0[0] = last ? vN[0][0] : vA[0][0]; w0[1] = last ? vN[0][1] : vA[0][1]; w1[0] = last ? vN[1][0] : vA[1][0]; w1[1] = last ? vN[1][1] : vA[1][1]; }
            else { w0[0] = vA[0][0]; w0[1] = vA[0][1]; w1[0] = vA[1][0]; w1[1] = vA[1][1]; }
            PG_LDB(B0, 0, 0); PG_LDB(B1, 0, 1); PG_SCHED; PG_LDA(At, 0, 0); PG_STAGE(PG_SA(1, 1), a1, vA[1]);
            PG_WAIT_V(8); PG_WAIT_L(0); PG_BAR; PG_MMA(0, 0, At, B0); PG_MMA(0, 1, At, B1); PG_BAR; PG_SCHED;
            PG_LDA(At, 0, 1); PG_STAGE(PG_SB(0, 0), b2, voffB); PG_STAGE(PG_SB(0, 1), b2 + hstepB, voffB); PG_STAGE(PG_SA(0, 0), a2, w0);
            PG_WAIT_V(8); PG_WAIT_L(0); PG_BAR; PG_MMA(1, 0, At, B0); PG_MMA(1, 1, At, B1); PG_BAR; PG_SCHED;
            PG_LDB(B0, 1, 0); PG_LDB(B1, 1, 1); PG_SCHED; PG_LDA(At, 1, 0); PG_STAGE(PG_SA(0, 1), a2, w1);
            PG_WAIT_V(8); PG_WAIT_L(0); PG_BAR; PG_MMA(0, 0, At, B0); PG_MMA(0, 1, At, B1); PG_BAR; PG_SCHED;
            PG_LDA(At, 1, 1); PG_STAGE(PG_SB(1, 0), b3, voffB); PG_STAGE(PG_SB(1, 1), b3 + hstepB, voffB); PG_STAGE(PG_SA(1, 0), a3, w0);
            PG_WAIT_V(8); PG_WAIT_L(0); PG_BAR; PG_MMA(1, 0, At, B0); PG_MMA(1, 1, At, B1); PG_BAR; PG_SCHED;
        }
        if (wr == 0) PG_BAR;
        { const int l2 = LANE_ID(); E(acc, cur, wr, wc, l2 & 15, l2 >> 4); }
        if (!has_next) break;
#pragma unroll
        for (int a = 0; a < 2; ++a)
#pragma unroll
            for (int b = 0; b < 2; ++b)
#pragma unroll
                for (int m = 0; m < 4; ++m)
#pragma unroll
                    for (int n = 0; n < 2; ++n) acc[a][b][m][n] = (f32x4){0.f, 0.f, 0.f, 0.f};
        cur = nxt; cA = nA; cB = nB; ++ui;
#pragma unroll
        for (int h = 0; h < 2; ++h)
#pragma unroll
            for (int i = 0; i < 2; ++i) vA[h][i] = vN[h][i];
        if (wr == 1) PG_BAR;
    }
    PG_WAIT_V(0);
    PG_BAR;
#undef PG_SA
#undef PG_SB
#undef PG_STAGE
#undef PG_LDA
#undef PG_LDB
#undef PG_MMA
#undef PG_WAIT_V
#undef PG_WAIT_L
#undef PG_BAR
#undef PG_SCHED
}

typedef f32x4 Acc[2][2][4][2];
#define EPI_FENCE() asm volatile("" ::: "memory")
#define EPI_BAR() do { LDS_WAIT(); __builtin_amdgcn_s_barrier(); asm volatile("" ::: "memory"); } while (0)
__device__ __forceinline__ float rstd4(const float* p, float inv_n) { return rsq(sum4(*(const f32x4*)p) * inv_n + EPS); }
__device__ __forceinline__ float fq_sum(float s) { s += __shfl_xor(s, 16); s += __shfl_xor(s, 32); return s; }

struct EpiCU {
    const float* ssq; bf16_t* V;
    __device__ __forceinline__ void operator()(Acc& acc, const Unit& u_, int wr, int wc, int fr, int fq) const {
        Unit u = u_; asm volatile("" : "+s"(u.pm), "+s"(u.pn), "+v"(fr), "+v"(fq));
        const int cg = wc * 32 + fq * 8;
#pragma unroll
        for (int ai = 0; ai < 2; ++ai)
#pragma unroll
            for (int m = 0; m < 4; ++m) {
                const int row = u.pm * BM + ai * HALF + wr * 64 + m * 16 + fr;
                const float rs = rstd4(ssq + (size_t)row * 4, 1.0f / D), r2 = rs * rs;
                const f32x4 v0 = acc[ai][0][m][0] * acc[ai][1][m][0] * r2, v1 = acc[ai][0][m][1] * acc[ai][1][m][1] * r2;
                *(u32x4*)(V + (size_t)row * D + u.pn * HALF + cg) = pack8(v0, v1);
            }
    }
};
struct EpiB {
    const float* ssq; const bf16_t* V; const float* cw; bf16_t* Gout;
    __device__ __forceinline__ void operator()(Acc& acc, const Unit& u_, int wr, int wc, int fr, int fq) const {
        Unit u = u_; asm volatile("" : "+s"(u.pm), "+s"(u.pn), "+v"(fr), "+v"(fq));
        float rs[2][4];
#pragma unroll
        for (int ai = 0; ai < 2; ++ai)
#pragma unroll
            for (int m = 0; m < 4; ++m) rs[ai][m] = rstd4(ssq + (size_t)(u.pm * BM + ai * HALF + wr * 64 + m * 16 + fr) * 4, 1.0f / D);
#pragma unroll
        for (int bj = 0; bj < 2; ++bj) {
            const int col = u.pn * BM + bj * HALF + wc * 32 + fq * 8;
            f32x4 w[3][2];
#pragma unroll
            for (int k = 0; k < 3; ++k) { w[k][0] = *(const f32x4*)(cw + k * D + col); w[k][1] = *(const f32x4*)(cw + k * D + col + 4); }
#pragma unroll
            for (int ai = 0; ai < 2; ++ai)
#pragma unroll
                for (int m = 0; m < 4; ++m) {
                    const int row = u.pm * BM + ai * HALF + wr * 64 + m * 16 + fr, s = row & (SEQ - 1);
                    const bf16_t* vp = V + (size_t)row * D + col;
                    const u32x4 z = (u32x4){0u, 0u, 0u, 0u};
                    const u32x4 x2 = *(const u32x4*)vp;
                    const u32x4 x1 = s >= 1 ? *(const u32x4*)(vp - D) : z;
                    const u32x4 x0 = s >= 2 ? *(const u32x4*)(vp - 2 * D) : z;
                    f32x4 c0, c1;
#pragma unroll
                    for (int q = 0; q < 4; ++q) {
                        const unsigned a0 = x0[q], a1 = x1[q], a2 = x2[q];
                        const float lo = __builtin_bit_cast(float, a0 << 16) * w[0][q >> 1][(q & 1) * 2] + __builtin_bit_cast(float, a1 << 16) * w[1][q >> 1][(q & 1) * 2] + __builtin_bit_cast(float, a2 << 16) * w[2][q >> 1][(q & 1) * 2];
                        const float hi = __builtin_bit_cast(float, a0 & 0xffff0000u) * w[0][q >> 1][(q & 1) * 2 + 1] + __builtin_bit_cast(float, a1 & 0xffff0000u) * w[1][q >> 1][(q & 1) * 2 + 1] + __builtin_bit_cast(float, a2 & 0xffff0000u) * w[2][q >> 1][(q & 1) * 2 + 1];
                        if (q < 2) { c0[(q & 1) * 2] = lo; c0[(q & 1) * 2 + 1] = hi; } else { c1[(q & 1) * 2] = lo; c1[(q & 1) * 2 + 1] = hi; }
                    }
                    const f32x4 g0 = acc[ai][bj][m][0] * rs[ai][m] * c0, g1 = acc[ai][bj][m][1] * rs[ai][m] * c1;
                    *(u32x4*)(Gout + (size_t)row * D + col) = pack8(g0, g1);
                    if (m & 1) EPI_FENCE();
                }
        }
    }
};
__device__ __forceinline__ void unpack8(u32x4 w, f32x4& a, f32x4& b) {
    a[0] = __builtin_bit_cast(float, w.x << 16); a[1] = __builtin_bit_cast(float, w.x & 0xffff0000u); a[2] = __builtin_bit_cast(float, w.y << 16); a[3] = __builtin_bit_cast(float, w.y & 0xffff0000u);
    b[0] = __builtin_bit_cast(float, w.z << 16); b[1] = __builtin_bit_cast(float, w.z & 0xffff0000u); b[2] = __builtin_bit_cast(float, w.w << 16); b[3] = __builtin_bit_cast(float, w.w & 0xffff0000u);
}
struct EpiRes {
    bf16_t* XB; float* ssq; LAS float* ex;
    __device__ __forceinline__ void operator()(Acc& acc, const Unit& u_, int wr, int wc, int fr, int fq) const {
        Unit u = u_; asm volatile("" : "+s"(u.pm), "+s"(u.pn), "+v"(fr), "+v"(fq));
#pragma unroll
        for (int ai = 0; ai < 2; ++ai)
#pragma unroll
            for (int m = 0; m < 4; ++m) {
                const int rl = ai * HALF + wr * 64 + m * 16 + fr, row = u.pm * BM + rl; float ss = 0.f;
#pragma unroll
                for (int bj = 0; bj < 2; ++bj) {
                    const size_t o = (size_t)row * D + u.pn * BM + bj * HALF + wc * 32 + fq * 8;
                    f32x4 b0, b1; unpack8(*(const u32x4*)(XB + o), b0, b1);
                    const f32x4 x0 = b0 + acc[ai][bj][m][0], x1 = b1 + acc[ai][bj][m][1];
                    *(u32x4*)(XB + o) = pack8(x0, x1);
                    ss += dot4(x0) + dot4(x1);
                }
                ss = fq_sum(ss);
                if (fq == 0) ex[rl * 4 + wc] = ss;
                if (m & 1) EPI_FENCE();
            }
        EPI_BAR();
        const int tx = (wr * 4 + wc) * 64 + fq * 16 + fr;
        if (tx < 256) ssq[(size_t)(u.pm * BM + tx) * 4 + u.pn] = sum4(*(const LAS f32x4*)(ex + tx * 4));
    }
};
__device__ __forceinline__ f32x4 silu_mul(f32x4 g, f32x4 u) {
    f32x4 r;
#pragma unroll
    for (int j = 0; j < 4; ++j) r[j] = g[j] * u[j] * __builtin_amdgcn_rcpf(1.0f + __builtin_amdgcn_exp2f(-1.4426950408889634f * g[j]));
    return r;
}
template <bool MOE> struct EpiGU {
    const float* ssq; bf16_t* act; int ldc; const int* tok;
    __device__ __forceinline__ void operator()(Acc& acc, const Unit& u_, int wr, int wc, int fr, int fq) const {
        Unit u = u_; asm volatile("" : "+s"(u.pm), "+s"(u.pn), "+v"(fr), "+v"(fq));
        const int cg = wc * 32 + fq * 8;
#pragma unroll
        for (int ai = 0; ai < 2; ++ai)
#pragma unroll
            for (int m = 0; m < 4; ++m) {
                const int row = u.pm * BM + ai * HALF + wr * 64 + m * 16 + fr;
                int srow = row; if (MOE) { srow = tok[row]; srow = srow < 0 ? 0 : srow; }
                const float rs = rstd4(ssq + (size_t)srow * 4, 1.0f / D);
                const f32x4 a0 = silu_mul(acc[ai][0][m][0] * rs, acc[ai][1][m][0] * rs), a1 = silu_mul(acc[ai][0][m][1] * rs, acc[ai][1][m][1] * rs);
                *(u32x4*)(act + (size_t)row * ldc + u.pn * HALF + cg) = pack8(a0, a1);
            }
    }
};
struct EpiMoeDn {
    const int* tok; const float* wsl; bf16_t* XB; float* outf; float* ssq; LAS float* ex;
    __device__ __forceinline__ void operator()(Acc& acc, const Unit& u_, int wr, int wc, int fr, int fq) const {
        Unit u = u_; asm volatile("" : "+s"(u.pm), "+s"(u.pn), "+v"(fr), "+v"(fq));
#pragma unroll
        for (int ai = 0; ai < 2; ++ai)
#pragma unroll
            for (int m = 0; m < 4; ++m) {
                const int rl = ai * HALF + wr * 64 + m * 16 + fr, slot = u.pm * BM + rl;
                const int tk = tok[slot]; const float w = wsl[slot]; float ss = 0.f;
                if (tk >= 0) {
#pragma unroll
                    for (int bj = 0; bj < 2; ++bj) {
                        const size_t o = (size_t)tk * D + u.pn * BM + bj * HALF + wc * 32 + fq * 8;
                        f32x4 b0, b1; unpack8(*(const u32x4*)(XB + o), b0, b1);
                        const f32x4 x0 = b0 + acc[ai][bj][m][0] * w, x1 = b1 + acc[ai][bj][m][1] * w;
                        if (outf) { *(f32x4*)(outf + o) = x0; *(f32x4*)(outf + o + 4) = x1; }
                        else *(u32x4*)(XB + o) = pack8(x0, x1);
                        if (ssq) ss += dot4(x0) + dot4(x1);
                    }
                }
                if (ssq) { ss = fq_sum(ss); if (fq == 0) ex[rl * 4 + wc] = ss; }
                if (m & 1) EPI_FENCE();
            }
        if (ssq) {
            EPI_BAR();
            const int tx = (wr * 4 + wc) * 64 + fq * 16 + fr;
            if (tx < 256) { const int tk = tok[u.pm * BM + tx]; if (tk >= 0) ssq[(size_t)tk * 4 + u.pn] = sum4(*(const LAS f32x4*)(ex + tx * 4)); }
        }
    }
};
struct EpiDown {
    const float* ssq; bf16_t* down; float* krope; float* mssq; LAS float* ex;
    __device__ __forceinline__ void operator()(Acc& acc, const Unit& u_, int wr, int wc, int fr, int fq) const {
        Unit u = u_; asm volatile("" : "+s"(u.pm), "+s"(u.pn), "+v"(fr), "+v"(fq));
        const int cg = wc * 32 + fq * 8;
#pragma unroll
        for (int ai = 0; ai < 2; ++ai)
#pragma unroll
            for (int m = 0; m < 4; ++m) {
                const int rl = ai * HALF + wr * 64 + m * 16 + fr, row = u.pm * BM + rl;
                const float rs = rstd4(ssq + (size_t)row * 4, 1.0f / D);
#pragma unroll
                for (int bj = 0; bj < 2; ++bj) {
                    const int seg = u.pn * 2 + bj;
                    const f32x4 y0 = acc[ai][bj][m][0] * rs, y1 = acc[ai][bj][m][1] * rs;
                    const float ss = fq_sum(dot4(y0) + dot4(y1));
                    if (fq == 0) ex[(bj * 256 + rl) * 4 + wc] = ss;
                    if (seg < 5) *(u32x4*)(down + (size_t)row * DOWNP + u.pn * BM + bj * HALF + cg) = pack8(y0, y1);
                    else if (wc < 2) { *(f32x4*)(krope + (size_t)row * 64 + cg) = y0; *(f32x4*)(krope + (size_t)row * 64 + cg + 4) = y1; }
                }
            }
        EPI_BAR();
        { const int tx = (wr * 4 + wc) * 64 + fq * 16 + fr, bj = tx >> 8, rl = tx & 255; const int seg = u.pn * 2 + bj, si = seg < 3 ? seg : (seg == 5 ? 3 : seg + 1); mssq[(size_t)(u.pm * BM + rl) * 8 + si] = sum4(*(const LAS f32x4*)(ex + (bj * 256 + rl) * 4)); }
    }
};
struct EpiQ {
    const float* mssq; const float* gq; const float* cosT; const float* sinT; bf16_t* Q; LAS float* ex;
    __device__ __forceinline__ void operator()(Acc& acc, const Unit& u_, int wr, int wc, int fr, int fq) const {
        Unit u = u_; asm volatile("" : "+s"(u.pm), "+s"(u.pn), "+v"(fr), "+v"(fq));
        const int cg = wc * 32 + fq * 8;
#pragma unroll
        for (int ai = 0; ai < 2; ++ai)
#pragma unroll
            for (int m = 0; m < 4; ++m) {
                const int rl = ai * HALF + wr * 64 + m * 16 + fr, row = u.pm * BM + rl;
                const f32x4 a = *(const f32x4*)(mssq + (size_t)row * 8);
                const float rs = rsq(((a[0] + a[1]) + a[2]) * (1.0f / 384.0f) + EPS);
                float ss = 0.f;
#pragma unroll
                for (int bj = 0; bj < 2; ++bj)
#pragma unroll
                    for (int n = 0; n < 2; ++n) { acc[ai][bj][m][n] = acc[ai][bj][m][n] * rs; ss += dot4(acc[ai][bj][m][n]); }
                ss = fq_sum(ss);
                if (fq == 0) ex[rl * 4 + wc] = ss;
                if (m & 1) EPI_FENCE();
            }
        EPI_BAR();
        const f32x4 g0 = *(const f32x4*)(gq + cg), g1 = *(const f32x4*)(gq + cg + 4);
        const int i0 = wc * 16 + fq * 4;
        f32x4 gr1 = (f32x4){0.f, 0.f, 0.f, 0.f}, gr2 = gr1;
        if (wc < 2) { gr1 = *(const f32x4*)(gq + 128 + i0); gr2 = *(const f32x4*)(gq + 160 + i0); }
#pragma unroll
        for (int ai = 0; ai < 2; ++ai)
#pragma unroll
            for (int m = 0; m < 4; ++m) {
                const int rl = ai * HALF + wr * 64 + m * 16 + fr, row = u.pm * BM + rl;
                const f32x4 e = *(const LAS f32x4*)(ex + rl * 4);
                const float rh = rsq(sum4(e) * (1.0f / DQK) + EPS) * QSCALE;
                bf16_t* qp = Q + (size_t)row * QPITCH + u.pn * DQK;
                *(u32x4*)(qp + cg) = pack8(acc[ai][0][m][0] * g0 * rh, acc[ai][0][m][1] * g1 * rh);
                if (wc < 2) {
                    const f32x4 x1 = acc[ai][1][m][0] * gr1 * rh, x2 = acc[ai][1][m][1] * gr2 * rh;
                    const f32x4 cs = *(const f32x4*)(cosT + (size_t)row * 32 + i0), sn = *(const f32x4*)(sinT + (size_t)row * 32 + i0);
                    const f32x4 o1 = x1 * cs - x2 * sn, o2 = x2 * cs + x1 * sn;
                    u32x2 w1, w2; w1.x = cvt_pk_bf16(o1[0], o1[1]); w1.y = cvt_pk_bf16(o1[2], o1[3]); w2.x = cvt_pk_bf16(o2[0], o2[1]); w2.y = cvt_pk_bf16(o2[2], o2[3]);
                    *(u32x2*)(qp + 128 + i0) = w1; *(u32x2*)(qp + 160 + i0) = w2;
                }
                EPI_FENCE();
            }
    }
};
struct EpiKV {
    const float* mssq; const float* krope; const float* gk; const float* cosT; const float* sinT; bf16_t* Kc; bf16_t* Vc; LAS float* ex;
    __device__ __forceinline__ void operator()(Acc& acc, const Unit& u_, int wr, int wc, int fr, int fq) const {
        Unit u = u_; asm volatile("" : "+s"(u.pm), "+s"(u.pn), "+v"(fr), "+v"(fq));
        const int cg = wc * 32 + fq * 8;
#pragma unroll
        for (int ai = 0; ai < 2; ++ai)
#pragma unroll
            for (int m = 0; m < 4; ++m) {
                const int rl = ai * HALF + wr * 64 + m * 16 + fr, row = u.pm * BM + rl;
                const f32x2 a = *(const f32x2*)(mssq + (size_t)row * 8 + 4);
                const float rs = rsq((a[0] + a[1]) * (1.0f / 256.0f) + EPS);
#pragma unroll
                for (int bj = 0; bj < 2; ++bj)
#pragma unroll
                    for (int n = 0; n < 2; ++n) acc[ai][bj][m][n] = acc[ai][bj][m][n] * rs;
                const float ss = fq_sum(dot4(acc[ai][0][m][0]) + dot4(acc[ai][0][m][1]));
                if (fq == 0) ex[rl * 4 + wc] = ss;
                if (m & 1) EPI_FENCE();
            }
        EPI_BAR();
        const f32x4 g0 = *(const f32x4*)(gk + cg), g1 = *(const f32x4*)(gk + cg + 4);
        const int i0 = wc * 8 + fq * 2;
        const f32x2 gr1 = *(const f32x2*)(gk + 128 + i0), gr2 = *(const f32x2*)(gk + 160 + i0);
#pragma unroll
        for (int ai = 0; ai < 2; ++ai)
#pragma unroll
            for (int m = 0; m < 4; ++m) {
                const int rl = ai * HALF + wr * 64 + m * 16 + fr, row = u.pm * BM + rl;
                const f32x4 e = *(const LAS f32x4*)(ex + rl * 4);
                const float rp = mssq[(size_t)row * 8 + 3];
                const float rk = rsq((sum4(e) + rp) * (1.0f / DQK) + EPS);
                bf16_t* kp = Kc + (size_t)row * QPITCH + u.pn * DQK;
                *(u32x4*)(kp + cg) = pack8(acc[ai][0][m][0] * g0 * rk, acc[ai][0][m][1] * g1 * rk);
                *(u32x4*)(Vc + (size_t)row * VPITCH + u.pn * DV + cg) = pack8(acc[ai][1][m][0], acc[ai][1][m][1]);
                const f32x2 x1 = *(const f32x2*)(krope + (size_t)row * 64 + i0) * gr1 * rk, x2 = *(const f32x2*)(krope + (size_t)row * 64 + 32 + i0) * gr2 * rk;
                const f32x2 cs = *(const f32x2*)(cosT + (size_t)row * 32 + i0), sn = *(const f32x2*)(sinT + (size_t)row * 32 + i0);
                const f32x2 o1 = x1 * cs - x2 * sn, o2 = x2 * cs + x1 * sn;
                *(unsigned*)(kp + 128 + i0) = cvt_pk_bf16(o1[0], o1[1]); *(unsigned*)(kp + 160 + i0) = cvt_pk_bf16(o2[0], o2[1]);
                EPI_FENCE();
            }
    }
};
}

namespace att {
constexpr int KP = 400, KT = 64 * KP  , VT = 16384;
constexpr int OFF_V = 0, OFF_K = 2 * VT, OFF_WS = OFF_K + 2 * KT, BYTES = OFF_WS + 8 * 256;
constexpr float THR2 = 8.0f;
#define SBAR() __builtin_amdgcn_sched_barrier(0)
__device__ __forceinline__ int v_st(int k, int c) { const int kk = (k & ~0xC) | ((k & 4) << 1) | ((k & 8) >> 1); return ((kk >> 3) * 4 + (c >> 5)) * 512 + ((kk & 7) * 32 + (c & 31)) * 2; }
__device__ __forceinline__ int v_rd_base(int lane) { return ((lane & 3) << 3) | (((lane >> 2) & 3) << 6) | (((lane >> 4) & 1) << 5) | (((lane >> 5) & 1) << 8); }
constexpr int v_rd_off(int d0, int ks, int half) { return d0 * 512 + ks * 4096 + half * 2048; }
__device__ __forceinline__ int crow(int r, int hi) { return (r & 3) + 8 * (r >> 2) + 4 * hi; }
__device__ __forceinline__ void mask_tile(f32x16& p0, f32x16& p1, int dq) {
    const float NEG = -__builtin_inff();
#pragma unroll
    for (int r = 0; r < 16; ++r) {
        const int c = (r & 3) + 8 * (r >> 2);
        if (dq - c < 0) p0[r] = NEG;
        if (dq - c - 32 < 0) p1[r] = NEG;
    }
}
__device__ __forceinline__ void attn_unit(const bf16_t* __restrict__ Q, const bf16_t* __restrict__ K, const bf16_t* __restrict__ V, bf16_t* __restrict__ O, int b, int h, int qb, LAS unsigned char* lds, const int wave) {
    int lane = LANE_ID(); asm volatile("" : "+v"(lane));
    const int wid = wave, r32 = lane & 31, hi = lane >> 5;
    const int q0 = qb * 256, NT = (q0 + 256) / 64, qlo = q0 + wid * 32;
    const size_t tok0 = (size_t)b * SEQ;
    unsigned kg[4], vg[2];
#pragma unroll
    for (int i = 0; i < 4; ++i) { const int pc = (wid + 8 * i) * 64 + lane, key = pc / 25; int cc = pc - key * 25; cc = cc == 24 ? 0 : cc; kg[i] = (unsigned)((key & 63) * QPITCH + cc * 8) * 2u; }
#pragma unroll
    for (int i = 0; i < 2; ++i) { const int pc = (wid + 8 * i) * 64 + lane, st = pc >> 5, w = pc & 31, kk = (st >> 2) * 8 + (w >> 2), c = (st & 3) * 32 + (w & 3) * 8;
        const int k = (kk & ~0xC) | ((kk & 4) << 1) | ((kk & 8) >> 1); vg[i] = (unsigned)(k * VPITCH + c) * 2u; }
    const char* Kh = (const char*)(K + tok0 * QPITCH + h * DQK); const char* Vh = (const char*)(V + tok0 * VPITCH + h * DV);
    LAS unsigned char* Vl = lds + OFF_V; LAS unsigned char* Kl = lds + OFF_K;
    LAS float* wsf = (LAS float*)(lds + OFF_WS) + wid * 64;
#define ADMA(t, bf) do { const char* kt_ = Kh + (size_t)(t) * 64 * QPITCH * 2; const char* vt_ = Vh + (size_t)(t) * 64 * VPITCH * 2; \
        _Pragma("unroll") for (int i = 0; i < 3; ++i) __builtin_amdgcn_global_load_lds((const unsigned*)(kt_ + kg[i]), (LAS unsigned*)(Kl + (bf) * KT + (wid + 8 * i) * 1024), 16, 0, 0); \
        if (wid == 0) __builtin_amdgcn_global_load_lds((const unsigned*)(kt_ + kg[3]), (LAS unsigned*)(Kl + (bf) * KT + 24 * 1024), 16, 0, 0); \
        _Pragma("unroll") for (int i = 0; i < 2; ++i) __builtin_amdgcn_global_load_lds((const unsigned*)(vt_ + vg[i]), (LAS unsigned*)(Vl + (bf) * VT + (wid + 8 * i) * 1024), 16, 0, 0); } while (0)
    bf16x8 qr[12];
    { const bf16_t* qp = Q + (tok0 + qlo + r32) * QPITCH + h * DQK + hi * 8;
#pragma unroll
      for (int d0 = 0; d0 < 12; ++d0) qr[d0] = *(const bf16x8*)(qp + d0 * 16); }
    ADMA(0, 0);
    VM_WAIT(); __builtin_amdgcn_s_barrier(); asm volatile("" ::: "memory");
    float m_reg = -1e30f, l_reg = 0.f; f32x16 o[4];
#pragma unroll
    for (int d = 0; d < 4; ++d) o[d] = f32x16{};
    const int kfb = r32 * KP + hi * 16;
    const int vrb = (int)(uintptr_t)Vl + v_rd_base(lane);
    for (int t = 0; t < NT; ++t) {
        const int bf = t & 1;
        if (t + 1 < NT) ADMA(t + 1, bf ^ 1);
        if (64 * t <= qlo + 31) {
            f32x16 p0 = f32x16{}, p1 = f32x16{};
            { const LAS unsigned char* kb = Kl + bf * KT + kfb;
#pragma unroll
              for (int d0 = 0; d0 < 12; ++d0) {
                  const bf16x8 b0 = *(const LAS bf16x8*)(kb + d0 * 32), b1 = *(const LAS bf16x8*)(kb + 32 * KP + d0 * 32);
                  p0 = __builtin_amdgcn_mfma_f32_32x32x16_bf16(b0, qr[d0], p0, 0, 0, 0);
                  p1 = __builtin_amdgcn_mfma_f32_32x32x16_bf16(b1, qr[d0], p1, 0, 0, 0); } }
            if (64 * t + 63 > qlo) mask_tile(p0, p1, qlo + r32 - 4 * hi - 64 * t);
            float pmax = p0[0];
#pragma unroll
            for (int r = 1; r < 16; ++r) pmax = fmaxf(pmax, p0[r]);
#pragma unroll
            for (int r = 0; r < 16; ++r) pmax = fmaxf(pmax, p1[r]);
            { auto rr = __builtin_amdgcn_permlane32_swap(__float_as_uint(pmax), __float_as_uint(pmax), false, false); pmax = fmaxf(__uint_as_float(rr[0]), __uint_as_float(rr[1])); }
            float mn, alpha;
            if (__builtin_expect(__all(pmax - m_reg <= THR2), 1)) { mn = m_reg; alpha = 1.f; }
            else { mn = fmaxf(m_reg, pmax); alpha = __builtin_amdgcn_exp2f(m_reg - mn); m_reg = mn; }
            float ps = 0.f;
#pragma unroll
            for (int r = 0; r < 16; ++r) { p0[r] = __builtin_amdgcn_exp2f(p0[r] - mn); ps += p0[r]; }
#pragma unroll
            for (int r = 0; r < 16; ++r) { p1[r] = __builtin_amdgcn_exp2f(p1[r] - mn); ps += p1[r]; }
            { auto rr = __builtin_amdgcn_permlane32_swap(__float_as_uint(ps), __float_as_uint(ps), false, false); ps = __uint_as_float(rr[0]) + __uint_as_float(rr[1]); }
            l_reg = l_reg * alpha + ps;
            bf16x8 pa0, pa1, pa2, pa3;
#define PK4(P, B_, OUT) do { unsigned a0 = cvt_pk_bf16(P[B_+0], P[B_+1]), a1 = cvt_pk_bf16(P[B_+2], P[B_+3]); \
        unsigned b0 = cvt_pk_bf16(P[B_+4], P[B_+5]), b1 = cvt_pk_bf16(P[B_+6], P[B_+7]); \
        auto r0 = __builtin_amdgcn_permlane32_swap(a0, b0, false, false); auto r1 = __builtin_amdgcn_permlane32_swap(a1, b1, false, false); \
        u32x4 w = {r0[0], r1[0], r0[1], r1[1]}; OUT = __builtin_bit_cast(bf16x8, w); } while (0)
            PK4(p0, 0, pa0); PK4(p0, 8, pa1); PK4(p1, 0, pa2); PK4(p1, 8, pa3);
#undef PK4
            if (__any(alpha < 1.f)) { if (hi == 0) wsf[r32] = alpha; LDS_WAIT();
#pragma unroll
                for (int d = 0; d < 4; ++d)
#pragma unroll
                    for (int r = 0; r < 16; ++r) o[d][r] *= wsf[crow(r, hi)]; }
            const int vb0 = vrb + bf * VT;
#define TRRD(dst, off) asm volatile("ds_read_b64_tr_b16 %0, %1 offset:%2" : "=&v"(dst) : "v"(vb0), "i"(off) : "memory")
#define PV_D0(d0) do { s16x4 l0, l1, l2, l3, h0, h1, h2, h3; constexpr int b_ = v_rd_off(d0, 0, 0); \
        TRRD(l0, b_); TRRD(h0, b_ + 2048); TRRD(l1, b_ + 4096); TRRD(h1, b_ + 6144); TRRD(l2, b_ + 8192); TRRD(h2, b_ + 10240); TRRD(l3, b_ + 12288); TRRD(h3, b_ + 14336); \
        asm volatile("s_waitcnt lgkmcnt(0)" ::: "memory"); SBAR(); \
        o[d0] = __builtin_amdgcn_mfma_f32_32x32x16_bf16(pa0, (bf16x8){l0[0], l0[1], l0[2], l0[3], h0[0], h0[1], h0[2], h0[3]}, o[d0], 0, 0, 0); \
        o[d0] = __builtin_amdgcn_mfma_f32_32x32x16_bf16(pa1, (bf16x8){l1[0], l1[1], l1[2], l1[3], h1[0], h1[1], h1[2], h1[3]}, o[d0], 0, 0, 0); \
        o[d0] = __builtin_amdgcn_mfma_f32_32x32x16_bf16(pa2, (bf16x8){l2[0], l2[1], l2[2], l2[3], h2[0], h2[1], h2[2], h2[3]}, o[d0], 0, 0, 0); \
        o[d0] = __builtin_amdgcn_mfma_f32_32x32x16_bf16(pa3, (bf16x8){l3[0], l3[1], l3[2], l3[3], h3[0], h3[1], h3[2], h3[3]}, o[d0], 0, 0, 0); } while (0)
            PV_D0(0); PV_D0(1); PV_D0(2); PV_D0(3);
#undef PV_D0
#undef TRRD
        }
        LDS_WAIT(); VM_WAIT(); __builtin_amdgcn_s_barrier(); asm volatile("" ::: "memory");
    }
    if (hi == 0) wsf[32 + r32] = l_reg; LDS_WAIT();
    bf16_t* Ow = O + (tok0 + qlo) * VPITCH + h * DV;
#pragma unroll
    for (int r = 0; r < 16; ++r) { const int orow = crow(r, hi); const float rl = __builtin_amdgcn_rcpf(wsf[32 + orow]);
#pragma unroll
        for (int d = 0; d < 4; ++d) { const float v = o[d][r] * rl; const float vn = __shfl_xor(v, 1);
            if ((r32 & 1) == 0) *(unsigned*)(Ow + (size_t)orow * VPITCH + d * 32 + r32) = cvt_pk_bf16(v, vn); } }
    LDS_WAIT();
#undef ADMA
}
#undef SBAR
}

#ifndef PH_MASK
#define PH_MASK 0xFFFF
#endif
#define PH(k) (((PH_MASK) >> (k)) & 1)
#ifndef PROBE_SA
#define PROBE_SA 1.0f
#endif
#ifndef PROBE_A0
#define PROBE_A0 0
#define PROBE_A1 1
#define PROBE_B0 1
#define PROBE_B1 2
#endif
constexpr int NWAVES = 8;
struct Args { const void* in[22]; float* out; unsigned char* ws; };
enum { I_X = 0, I_POS, I_NMIX, I_NFFN, I_CWIN, I_CW, I_CWOUT, I_MDOWN, I_MQAN, I_MKVAN, I_MUQ, I_MUKV, I_MQN, I_MKN, I_MWO, I_FG, I_FU, I_FD, I_MR, I_MG, I_MU, I_MD };

__device__ const double INVF[32] = {
    1.0, 0.7498942093324559, 0.5623413251903491, 0.4216965034285822, 0.31622776601683794, 0.23713737056616552, 0.1778279410038923, 0.1333521432163324,
    0.1, 0.07498942093324558, 0.05623413251903491, 0.04216965034285822, 0.03162277660168379, 0.023713737056616554, 0.01778279410038923, 0.01333521432163324,
    0.01, 0.007498942093324559, 0.005623413251903491, 0.004216965034285823, 0.0031622776601683794, 0.0023713737056616554, 0.0017782794100389228, 0.001333521432163324,
    0.001, 0.0007498942093324559, 0.0005623413251903491, 0.0004216965034285823, 0.00031622776601683794, 0.00023713737056616554, 0.00017782794100389227, 0.0001333521432163324};

__device__ __forceinline__ const float* wsrc4(const float* s0, const float* s1, int kind, int n) {
    if (kind == 0) return s0 + n;
    if (kind == 1) { const int ch = (n >> 8) * 128 + (n & 127); return (((n >> 7) & 1) ? s1 : s0) + ch; }
    if (kind == 2) return n < 704 ? s0 + n : (const float*)nullptr;
    const int hh = n >> 8, c = n & 255;
    if (c < 128) return s0 + hh * DQK + c;
    if (c < 192) { const int cc = c - 128, g = cc >> 5, rr = cc & 31, q = rr >> 3, nn = (rr >> 2) & 1, i = g * 16 + q * 4; return s0 + hh * DQK + 128 + nn * 32 + i; }
    return (const float*)nullptr;
}
constexpr int TR_PITCH = 136;
__device__ __forceinline__ void tr_item64(const float* s0, const float* s1, const float* gain, bf16_t* dst, int ld, int K, int kind, LAS unsigned char* scr, int kb, int nb, int ln) {
    const int k0 = 64 * kb, n0 = 64 * nb, kq = ln >> 4, n4 = ln & 15;
    const float* colp = wsrc4(s0, s1, kind, n0 + 4 * n4);
    f32x4 v[16];
#pragma unroll
    for (int i = 0; i < 16; ++i) v[i] = colp ? *(const f32x4*)(colp + (size_t)(k0 + 4 * i + kq) * ld) : (f32x4){0.f, 0.f, 0.f, 0.f};
    if (gain) {
#pragma unroll
        for (int i = 0; i < 16; ++i) v[i] = v[i] * gain[k0 + 4 * i + kq];
    }
#pragma unroll
    for (int i = 0; i < 16; ++i) { u32x2 w; w.x = cvt_pk_bf16(v[i][0], v[i][1]); w.y = cvt_pk_bf16(v[i][2], v[i][3]); *(LAS u32x2*)(scr + (4 * i + kq) * TR_PITCH + n4 * 8) = w; }
    LDS_WAIT(); asm volatile("" ::: "memory");
    const int k8 = ln & 7, nr = ln >> 3;
#pragma unroll
    for (int jj = 0; jj < 8; ++jj) { const int n = jj * 8 + nr; const LAS unsigned short* sp = (const LAS unsigned short*)(scr + (k8 * 8) * TR_PITCH + n * 2);
        u32x4 o;
        o.x = (unsigned)sp[0 * (TR_PITCH / 2)] | ((unsigned)sp[1 * (TR_PITCH / 2)] << 16); o.y = (unsigned)sp[2 * (TR_PITCH / 2)] | ((unsigned)sp[3 * (TR_PITCH / 2)] << 16);
        o.z = (unsigned)sp[4 * (TR_PITCH / 2)] | ((unsigned)sp[5 * (TR_PITCH / 2)] << 16); o.w = (unsigned)sp[6 * (TR_PITCH / 2)] | ((unsigned)sp[7 * (TR_PITCH / 2)] << 16);
        *(u32x4*)(dst + (size_t)(n0 + n) * K + k0 + 8 * k8) = o; }
    LDS_WAIT(); asm volatile("" ::: "memory");
}

__global__ void __launch_bounds__(NWAVES * 64, 2) fwd(Args args) {
    extern __shared__ __attribute__((aligned(16))) unsigned char lds_raw[];
    LAS unsigned char* lds = (LAS unsigned char*)lds_raw;
    volatile LAS unsigned* MISC = (volatile LAS unsigned*)(lds + MISC_OFF);
    const int wave = __builtin_amdgcn_readfirstlane((int)threadIdx.x >> 6);
#define tid (wave * 64 + LANE_ID())
#define lane LANE_ID()
    const int G = gridDim.x, bx = blockIdx.x;
    const int vcu = (G % 8 == 0) ? (bx % 8) * (G / 8) + bx / 8 : bx;
    unsigned char* ws = args.ws;
    unsigned* ctl = (unsigned*)(ws + WS_CTL);
    for (int u = tid; u < (LDS_BYTES - EX_OFF) / 4; u += NWAVES * 64) ((LAS unsigned*)(lds + EX_OFF))[u] = 0u;
    __syncthreads();
    XcdBarrier bar = xcd_barrier_post(ctl + CW_BAR, MISC + 8, wave);
#ifndef PROBE
#define PROBE 0
#endif
#if PROBE
    unsigned long long* TS = (unsigned long long*)(ws + WS_CTL + 65536);
    int n_stamp = 0;
#define STAMP() do { if (bx == 0 && wave == 0 && LANE_ID() == 0) TS[n_stamp] = __builtin_amdgcn_s_memrealtime(); ++n_stamp; } while (0)
#else
#define STAMP() do { } while (0)
#endif
    STAMP();
#define GRID_BAR() do { xcd_barrier(bar, wave); STAMP(); } while (0)

    float* out = args.out; int bxl = bx; int zi = 0;
    LAS float* const EX = (LAS float*)(lds + EX_OFF);
    LAS int* const PFX = (LAS int*)(lds + TAB_OFF);
#define WSP(T_, off) ((T_*)(ws + (off)))
#define ARP(off) ((bf16_t*)(ws + WS_AR + (off)))
#define WTP(off) ((bf16_t*)(ws + WS_W + (off)))
#define INF(k) ((const float*)args.in[(k) + zi])

    for (int j = 0; j < 2; ++j) {
#define LAUNDER() do { asm volatile("" : "+s"(ws)); asm volatile("" : "+s"(out)); asm volatile("" : "+s"(bxl)); zi = 0; asm volatile("" : "+s"(zi)); } while (0)
        LAUNDER();
        if constexpr (PH(0))
        {
            int ln = LANE_ID(); asm volatile("" : "+v"(ln));
            LAS unsigned char* scr = lds + wave * 16384;
            const int gw = vcu * NWAVES + wave, NGW = G * NWAVES;
            constexpr int C_CU = 16 * 32, C_B = 16 * 16, C_OUT = 16 * 16, C_GU = 16 * 88, C_DN = 44 * 16, C_DOWN = 16 * 12, C_UQ = 6 * 32, C_UKV = 4 * 32, C_O = 16 * 16, C_MGU1 = 16 * 64, C_MDN1 = 32 * 16;
            constexpr int NIT = C_CU + C_B + C_OUT + C_GU + C_DN + C_DOWN + C_UQ + C_UKV + C_O + NE * C_MGU1 + NE * C_MDN1;
            for (int it = gw; it < NIT; it += NGW) {
                int r = it; const float* d_s0 = nullptr; const float* d_s1 = nullptr; const float* d_gain = nullptr; bf16_t* d_dst = nullptr; int d_ld = 0, d_K = 0, d_nblk = 1, d_kind = 0;
                if (r < C_CU) { const float* cwin = INF(I_CWIN) + (size_t)j * D * 3 * D; d_s0 = cwin + D; d_s1 = cwin + 2 * D; d_ld = 3 * D; d_gain = INF(I_NMIX) + (2 * j) * D; d_K = D; d_nblk = 32; d_kind = 1; d_dst = WTP(W_CU); }
                else if ((r -= C_CU) < C_B) { d_s0 = INF(I_CWIN) + (size_t)j * D * 3 * D; d_ld = 3 * D; d_gain = INF(I_NMIX) + (2 * j) * D; d_K = D; d_nblk = 16; d_dst = WTP(W_B); }
                else if ((r -= C_B) < C_OUT) { d_s0 = INF(I_CWOUT) + (size_t)j * D * D; d_ld = D; d_K = D; d_nblk = 16; d_dst = WTP(W_OUT); }
                else if ((r -= C_OUT) < C_GU) { d_s0 = INF(I_FG) + (size_t)j * D * DFF; d_s1 = INF(I_FU) + (size_t)j * D * DFF; d_ld = DFF; d_gain = INF(I_NFFN) + (2 * j) * D; d_K = D; d_nblk = 88; d_kind = 1; d_dst = WTP(W_GU); }
                else if ((r -= C_GU) < C_DN) { d_s0 = INF(I_FD) + (size_t)j * DFF * D; d_ld = D; d_K = DFF; d_nblk = 16; d_dst = WTP(W_DN); }
                else if ((r -= C_DN) < C_DOWN) { d_s0 = INF(I_MDOWN) + (size_t)j * D * 704; d_ld = 704; d_gain = INF(I_NMIX) + (2 * j + 1) * D; d_K = D; d_nblk = 12; d_kind = 2; d_dst = WTP(W_DOWN); }
                else if ((r -= C_DOWN) < C_UQ) { d_s0 = INF(I_MUQ) + (size_t)j * 384 * 1536; d_ld = 1536; d_gain = INF(I_MQAN) + j * 384; d_K = 384; d_nblk = 32; d_kind = 3; d_dst = WTP(W_UQ); }
                else if ((r -= C_UQ) < C_UKV) { d_s0 = INF(I_MUKV) + (size_t)j * 256 * 2048; d_ld = 2048; d_gain = INF(I_MKVAN) + j * 256; d_K = 256; d_nblk = 32; d_dst = WTP(W_UKV); }
                else if ((r -= C_UKV) < C_O) { d_s0 = INF(I_MWO) + (size_t)j * D * D; d_ld = D; d_K = D; d_nblk = 16; d_dst = WTP(W_O); }
                else if ((r -= C_O) < NE * C_MGU1) { const int e = r / C_MGU1; r -= e * C_MGU1; d_s0 = INF(I_MG) + ((size_t)j * NE + e) * D * DFE; d_s1 = INF(I_MU) + ((size_t)j * NE + e) * D * DFE; d_ld = DFE; d_gain = INF(I_NFFN) + (2 * j + 1) * D;
                    d_K = D; d_nblk = 64; d_kind = 1; d_dst = WTP(W_MGU) + (size_t)e * 4096 * D; }
                else { r -= NE * C_MGU1; const int e = r / C_MDN1; r -= e * C_MDN1; d_s0 = INF(I_MD) + ((size_t)j * NE + e) * DFE * D; d_ld = D; d_K = DFE; d_nblk = 16; d_dst = WTP(W_MDN) + (size_t)e * D * DFE; }
                tr_item64(d_s0, d_s1, d_gain, d_dst, d_ld, d_K, d_kind, scr, r / d_nblk, r % d_nblk, ln);
            }
            if (j == 0) {
                const int* pos = (const int*)INF(I_POS); const float* x_in = INF(I_X);
                bf16_t* XB = WSP(bf16_t, WS_XB); float* SSQ = WSP(float, WS_SSQ); float* COS = WSP(float, WS_COS); float* SIN = WSP(float, WS_SIN);
                for (int m = gw; m < T; m += NGW) {
                    const f32x4* xr = (const f32x4*)(x_in + (size_t)m * D) + ln;
                    f32x4 v[4]; float s = 0.f;
#pragma unroll
                    for (int q = 0; q < 4; ++q) { v[q] = xr[64 * q]; s += dot4(v[q]); }
                    s = wave_sum(s);
                    u32x2* o8 = (u32x2*)(XB + (size_t)m * D) + ln;
#pragma unroll
                    for (int q = 0; q < 4; ++q) { u32x2 w; w.x = cvt_pk_bf16(v[q][0], v[q][1]); w.y = cvt_pk_bf16(v[q][2], v[q][3]); o8[64 * q] = w; }
                    if (ln < 4) SSQ[(size_t)m * 4 + ln] = ln == 0 ? s : 0.f;
                    if (ln < 32) {
                        const double a = (double)pos[m] * INVF[ln];
                        const double n = __builtin_rint(a * 0.15915494309189535);
                        const float rr = (float)(a - n * 6.283185307179586);
                        COS[(size_t)m * 32 + ln] = cosf(rr); SIN[(size_t)m * 32 + ln] = sinf(rr);
                    }
                }
            }
        }
        GRID_BAR();
        LAUNDER();
        if constexpr (PH(1))
        {
            pg::SchedPlain S{WSP(bf16_t, WS_XB), D, WTP(W_CU), D, T / 256, 8, G, bxl};
            pg::EpiCU E{WSP(float, WS_SSQ), ARP(AR_V)};
            pg::gemm_phase(lds, D, S, E, wave);
        }
        GRID_BAR();
        LAUNDER();
        if constexpr (PH(2))
        {
            pg::SchedPlain S{WSP(bf16_t, WS_XB), D, WTP(W_B), D, T / 256, 4, G, bxl};
            pg::EpiB E{WSP(float, WS_SSQ), ARP(AR_V), INF(I_CW) + (size_t)j * 3 * D, ARP(AR_G)};
            pg::gemm_phase(lds, D, S, E, wave);
        }
        GRID_BAR();
        LAUNDER();
        if constexpr (PH(3))
        {
            pg::SchedPlain S{ARP(AR_G), D, WTP(W_OUT), D, T / 256, 4, G, bxl};
            pg::EpiRes E{WSP(bf16_t, WS_XB), WSP(float, WS_SSQ), EX};
            pg::gemm_phase(lds, D, S, E, wave);
        }
        GRID_BAR();
        LAUNDER();
        if constexpr (PH(4))
        {
            pg::SchedPlain S{WSP(bf16_t, WS_XB), D, WTP(W_GU), D, T / 256, 22, G, bxl};
            pg::EpiGU<false> E{WSP(float, WS_SSQ), ARP(AR_ACT), DFF, nullptr};
            pg::gemm_phase(lds, D, S, E, wave);
        }
        GRID_BAR();
        LAUNDER();
        if constexpr (PH(5))
        {
            pg::SchedPlain S{ARP(AR_ACT), DFF, WTP(W_DN), DFF, T / 256, 4, G, bxl};
            pg::EpiRes E{WSP(bf16_t, WS_XB), WSP(float, WS_SSQ), EX};
            pg::gemm_phase(lds, DFF, S, E, wave);
        }
        GRID_BAR();
        LAUNDER();
        if constexpr (PH(6))
        {
            pg::SchedPlain S{WSP(bf16_t, WS_XB), D, WTP(W_DOWN), D, T / 256, 3, G, bxl};
            pg::EpiDown E{WSP(float, WS_SSQ), ARP(AR_DOWN), WSP(float, WS_KROPE), WSP(float, WS_MSSQ), EX};
            pg::gemm_phase(lds, D, S, E, wave);
        }
        GRID_BAR();
        LAUNDER();
        if constexpr (PH(7))
        {
            pg::SchedPlain S{ARP(AR_DOWN), DOWNP, WTP(W_UQ), 384, T / 256, 8, G, bxl};
            pg::EpiQ E{WSP(float, WS_MSSQ), INF(I_MQN) + j * DQK, WSP(float, WS_COS), WSP(float, WS_SIN), ARP(AR_Q), EX};
            pg::gemm_phase(lds, 384, S, E, wave);
        }
        LAUNDER();
        if constexpr (PH(8))
        {
            pg::SchedPlain S{ARP(AR_DOWN) + 384, DOWNP, WTP(W_UKV), 256, T / 256, 8, G, bxl};
            pg::EpiKV E{WSP(float, WS_MSSQ), WSP(float, WS_KROPE), INF(I_MKN) + j * DQK, WSP(float, WS_COS), WSP(float, WS_SIN), ARP(AR_K), ARP(AR_VV), EX};
            pg::gemm_phase(lds, 256, S, E, wave);
        }
        GRID_BAR();
        LAUNDER();
        if constexpr (PH(9))
        {
            const bf16_t* Qp = ARP(AR_Q); const bf16_t* Kp = ARP(AR_K); const bf16_t* Vp = ARP(AR_VV); bf16_t* Op = ARP(AR_O);
            for (int it = vcu; it < NBATCH * NH * 4; it += G) {
                const int bh = it >> 2, pr = it & 3, b = bh >> 3, h = bh & 7;
                for (int pass = 0; pass < 2; ++pass) att::attn_unit(Qp, Kp, Vp, Op, b, h, pass == 0 ? 7 - pr : pr, lds, wave);
            }
        }
        GRID_BAR();
        LAUNDER();
        if constexpr (PH(10))
        {
            pg::SchedPlain S{ARP(AR_O), D, WTP(W_O), D, T / 256, 4, G, bxl};
            pg::EpiRes E{WSP(bf16_t, WS_XB), WSP(float, WS_SSQ), EX};
            pg::gemm_phase(lds, D, S, E, wave);
        }
        GRID_BAR();
        LAUNDER();
        if constexpr (PH(11))
        {
            int tl = wave * 64 + LANE_ID(); asm volatile("" : "+v"(tl)); const int ln = tl & 63;
            LAS float* GR = (LAS float*)lds;
            LAS int* LC = (LAS int*)(lds + 32768);
            int* ME = WSP(int, WS_ME); float* MW = WSP(float, WS_MW); int* WGCNT = WSP(int, WS_WGCNT); const bf16_t* XBr = WSP(bf16_t, WS_XB);
            const float* nffn1 = INF(I_NFFN) + (2 * j + 1) * D; const float* rt = INF(I_MR) + (size_t)j * D * NE;
            for (int i = tl; i < D * NE; i += NWAVES * 64) { const int k = i >> 3, e = i & 7; GR[e * D + k] = nffn1[k] * rt[i]; }
            for (int ch = bx; ch < T / 128; ch += G) {
                if (tl < 16) LC[tl] = 0;
                __syncthreads();
                for (int q = 0; q < 16; ++q) {
                    const int tk = ch * 128 + wave * 16 + q;
                    const u32x2* xr = (const u32x2*)(XBr + (size_t)tk * D) + ln;
                    f32x4 v[4]; float s = 0.f, lg[8];
#pragma unroll
                    for (int qq = 0; qq < 4; ++qq) { const u32x2 w = xr[64 * qq]; v[qq][0] = __builtin_bit_cast(float, w.x << 16); v[qq][1] = __builtin_bit_cast(float, w.x & 0xffff0000u); v[qq][2] = __builtin_bit_cast(float, w.y << 16); v[qq][3] = __builtin_bit_cast(float, w.y & 0xffff0000u); s += dot4(v[qq]); }
#pragma unroll
                    for (int e = 0; e < 8; ++e) { float a = 0.f;
#pragma unroll
                        for (int qq = 0; qq < 4; ++qq) { const f32x4 g = *(const LAS f32x4*)(GR + e * D + 4 * ln + 256 * qq); a += (v[qq][0] * g[0] + v[qq][1] * g[1]) + (v[qq][2] * g[2] + v[qq][3] * g[3]); }
                        lg[e] = wave_sum(a); }
                    s = wave_sum(s);
                    const float rs = rsq(s * (1.0f / D) + EPS);
                    int e1 = 0; float l1 = lg[0];
#pragma unroll
                    for (int e = 1; e < 8; ++e) if (lg[e] > l1) { l1 = lg[e]; e1 = e; }
                    int e2 = 0; float l2 = -__builtin_inff();
#pragma unroll
                    for (int e = 0; e < 8; ++e) if (e != e1 && lg[e] > l2) { l2 = lg[e]; e2 = e; }
                    const float ex = __expf((l2 - l1) * rs), w1 = 1.0f / (1.0f + ex), w2 = ex / (1.0f + ex);
                    if (ln == 0) {
                        const int r1 = atomicAdd((int*)&LC[e1], 1), r2 = atomicAdd((int*)&LC[8 + e2], 1);
                        ME[tk] = e1 | (e2 << 4) | (r1 << 8) | (r2 << 16); MW[2 * tk] = w1; MW[2 * tk + 1] = w2;
                    }
                }
                __syncthreads();
                if (tl < 16) WGCNT[ch * 16 + tl] = LC[tl];
                __syncthreads();
            }
        }
        GRID_BAR();
        LAUNDER();
        if constexpr (PH(12))
        {
            int tl = wave * 64 + LANE_ID(); asm volatile("" : "+v"(tl));
            LAS int* PART = (LAS int*)lds;
            LAS int* BASE = (LAS int*)(lds + 4096);
            LAS int* OFFS = (LAS int*)(lds + 4096 + 64);
            int* ME = WSP(int, WS_ME); float* MW = WSP(float, WS_MW); int* WGCNT = WSP(int, WS_WGCNT); int* TOK = WSP(int, WS_TOK); float* WSL = WSP(float, WS_WSL); int* TAB = WSP(int, WS_TAB);
            { const int l = tl & 15, part = tl >> 4; int s = 0;
              for (int c = 0; c < 8; ++c) s += WGCNT[(part * 8 + c) * 16 + l];
              PART[part * 16 + l] = s; }
            __syncthreads();
            if (tl < 16) { int run = 0; for (int p = 0; p < 32; ++p) { const int v = PART[p * 16 + tl]; PART[p * 16 + tl] = run; run += v; } OFFS[tl] = run; }
            __syncthreads();
            if (tl == 0) { int tp = 0; for (int l = 0; l < 16; ++l) { BASE[l] = tp * 256; PFX[l] = tp; tp += (OFFS[l] + 255) >> 8; } PFX[16] = tp;
                if (bx == 0) { for (int l = 0; l <= 16; ++l) TAB[l] = PFX[l]; } }
            __syncthreads();
            if (bx < 16) { const int l = bx, tot = OFFS[l], b0 = BASE[l], e0 = b0 + (((tot + 255) >> 8) << 8);
                for (int s = b0 + tot + tl; s < e0; s += NWAVES * 64) { TOK[s] = -1; WSL[s] = 0.f; } }
            __syncthreads();
            for (int ch = bx; ch < T / 128; ch += G) {
                if (tl < 16) { int o = BASE[tl] + PART[(ch >> 3) * 16 + tl]; for (int c = (ch & ~7); c < ch; ++c) o += WGCNT[c * 16 + tl]; OFFS[tl] = o; }
                __syncthreads();
                if (tl < 128) { const int tk = ch * 128 + tl, me = ME[tk]; const int e1 = me & 15, e2 = (me >> 4) & 15, r1 = (me >> 8) & 255, r2 = (me >> 16) & 255;
                    const int s1 = OFFS[e1] + r1, s2 = OFFS[8 + e2] + r2;
                    TOK[s1] = tk; WSL[s1] = MW[2 * tk]; TOK[s2] = tk; WSL[s2] = MW[2 * tk + 1]; }
                __syncthreads();
            }
        }
        GRID_BAR();
        if (tid <= 16) PFX[tid] = WSP(int, WS_TAB)[tid];
        __syncthreads();
        LAUNDER();
        if constexpr (PH(13))
        {
            pg::SchedMoeGU S{WSP(bf16_t, WS_XB), WSP(int, WS_TOK), WTP(W_MGU), PFX, PFX[16], G, bxl};
            pg::EpiGU<true> E{WSP(float, WS_SSQ), ARP(AR_ACT), DFE, WSP(int, WS_TOK)};
            pg::gemm_phase(lds, D, S, E, wave);
        }
        GRID_BAR();
        LAUNDER();
        if constexpr (PH(14))
        {
            pg::SchedMoeDn S{ARP(AR_ACT), WTP(W_MDN), PFX, 0, PFX[8], G, bxl};
            pg::EpiMoeDn E{WSP(int, WS_TOK), WSP(float, WS_WSL), WSP(bf16_t, WS_XB), nullptr, nullptr, EX};
            pg::gemm_phase(lds, DFE, S, E, wave);
        }
        GRID_BAR();
        LAUNDER();
        if constexpr (PH(15))
        {
            pg::SchedMoeDn S{ARP(AR_ACT), WTP(W_MDN), PFX, PFX[8], PFX[16] - PFX[8], G, bxl};
            pg::EpiMoeDn E{WSP(int, WS_TOK), WSP(float, WS_WSL), WSP(bf16_t, WS_XB), j == 0 ? nullptr : out, j == 0 ? WSP(float, WS_SSQ) : nullptr, EX};
            pg::gemm_phase(lds, DFE, S, E, wave);
        }
        if (j == 0) GRID_BAR();
    }
#if PROBE
    GRID_BAR();
    {
        float da = 0.f, db = 0.f;
        for (int i = PROBE_A0; i < PROBE_A1; ++i) da += (float)(long long)(TS[i + 1] - TS[i]) * 0.01f;
        for (int i = PROBE_B0; i < PROBE_B1; ++i) db += (float)(long long)(TS[i + 1] - TS[i]) * 0.01f;
        const float delta = __builtin_sqrtf(da * 1e-6f * PROBE_SA);
        const int tl = wave * 64 + LANE_ID();
        for (size_t i = (size_t)bx * 512 + tl; i < (size_t)T * D / 4; i += (size_t)G * 512) { f32x4 v = ((f32x4*)out)[i]; v = v * (1.0f + delta); ((f32x4*)out)[i] = v; }
        __syncthreads();
        if (bx == 0 && tl == 0) out[0] += db * 0.02f;
    }
#endif
}

#undef tid
#undef lane
extern "C" void kernel_launch(void* const* d_in, const int* in_sizes, int n_in, void* d_out, int out_size, void* d_ws, size_t ws_size, hipStream_t stream) {
    static int grid = 0;
    if (grid == 0) {
        if (n_in != 22 || out_size != T * D || ws_size < WS_END) { fprintf(stderr, "kernel_launch: unexpected shapes (n_in %d, out %d, ws %zu)\n", n_in, out_size, ws_size); grid = -1; return; }
        int dev = 0, cus = 0;
        if (hipGetDevice(&dev) != hipSuccess || hipDeviceGetAttribute(&cus, hipDeviceAttributeMultiprocessorCount, dev) != hipSuccess) { grid = -1; return; }
        if (hipFuncSetAttribute((const void*)fwd, hipFuncAttributeMaxDynamicSharedMemorySize, LDS_BYTES) != hipSuccess) { fprintf(stderr, "kernel_launch: hipFuncSetAttribute failed\n"); grid = -1; return; }
        int per_cu = 0;
        if (hipOccupancyMaxActiveBlocksPerMultiprocessor(&per_cu, (const void*)fwd, NWAVES * 64, LDS_BYTES) != hipSuccess || per_cu < 1) fprintf(stderr, "kernel_launch: occupancy query says %d\n", per_cu);
        (void)hipGetLastError();
        grid = cus;
    }
    if (grid < 0) return;
    (void)hipMemsetAsync((char*)d_ws + WS_CTL, 0, CTL_ZERO_BYTES, stream);
    Args a{};
    for (int i = 0; i < 22; ++i) a.in[i] = d_in[i];
    a.out = (float*)d_out; a.ws = (unsigned char*)d_ws;
    hipLaunchKernelGGL(fwd, dim3(grid), dim3(NWAVES * 64), LDS_BYTES, stream, a);
}
```

```cpp
#include <hip/hip_runtime.h>
#include <cstdio>
#include <cstdint>

#define LAS __attribute__((address_space(3)))
#define GAS __attribute__((address_space(1)))
typedef unsigned short bf16_t;
typedef short bf16x8 __attribute__((ext_vector_type(8)));
typedef short s16x4 __attribute__((ext_vector_type(4)));
typedef float f32x2 __attribute__((ext_vector_type(2)));
typedef float f32x4 __attribute__((ext_vector_type(4)));
typedef float f32x16 __attribute__((ext_vector_type(16)));
typedef unsigned u32x2 __attribute__((ext_vector_type(2)));
typedef unsigned u32x4 __attribute__((ext_vector_type(4)));
typedef GAS unsigned gu32;

constexpr int T = 32768, D = 1024, SEQ = 2048, NBATCH = 16, NH = 8;
constexpr int DQK = 192, DV = 128, QPITCH = NH * DQK  , VPITCH = NH * DV  ;
constexpr int DFF = 2816, DFE = 2048, NE = 8;
constexpr int DOWNP = 768;
constexpr float EPS = 1e-6f;
constexpr float QSCALE = 0.07216878364870322f * 1.4426950408889634f;
constexpr int MAXSLOT = 65536 + 16 * 256;

constexpr size_t MiB = 1u << 20;
constexpr size_t WS_CTL = 0, CTL_ZERO_BYTES = 1 * MiB;
constexpr size_t WS_SSQ = 1 * MiB;
constexpr size_t WS_MSSQ = 3 * MiB;
constexpr size_t WS_KROPE = 6 * MiB;
constexpr size_t WS_COS = 14 * MiB, WS_SIN = 18 * MiB;
constexpr size_t WS_ME = 22 * MiB;
constexpr size_t WS_MW = 22 * MiB + 256 * 1024;
constexpr size_t WS_WGCNT = 23 * MiB;
constexpr size_t WS_TAB = 23 * MiB + 64 * 1024;
constexpr size_t WS_TOK = 24 * MiB;
constexpr size_t WS_WSL = 24 * MiB + 512 * 1024;
constexpr size_t WS_XB = 26 * MiB;
constexpr size_t WS_W = 90 * MiB;
constexpr size_t W_CU = 0, W_B = 4 * MiB, W_OUT = 6 * MiB, W_GU = 8 * MiB, W_DN = 19 * MiB, W_DOWN = 25 * MiB, W_UQ = 26 * MiB + 512 * 1024,
                 W_UKV = 28 * MiB, W_O = 29 * MiB, W_MGU = 32 * MiB, W_MDN = 96 * MiB;
constexpr size_t WS_AR = 218 * MiB;
constexpr size_t AR_V = 0, AR_G = 64 * MiB;
constexpr size_t AR_ACT = 0;
constexpr size_t AR_DOWN = 0, AR_Q = 64 * MiB, AR_K = 160 * MiB, AR_VV = 256 * MiB, AR_O = 0;
constexpr size_t WS_END = 538 * MiB;

constexpr int CW_BAR = 4096;

constexpr int RING_BYTES = 131072;
constexpr int EX_OFF = RING_BYTES;
constexpr int TAB_OFF = EX_OFF + 8192;
constexpr int MISC_OFF = TAB_OFF + 256;
constexpr int LDS_BYTES = MISC_OFF + 128 + 1024;

__device__ __forceinline__ unsigned cvt_pk_bf16(float lo, float hi) { unsigned r; asm volatile("v_cvt_pk_bf16_f32 %0, %1, %2" : "=v"(r) : "v"(lo), "v"(hi)); return r; }
__device__ __forceinline__ u32x4 pack8(f32x4 a, f32x4 b) { u32x4 w; w.x = cvt_pk_bf16(a[0], a[1]); w.y = cvt_pk_bf16(a[2], a[3]); w.z = cvt_pk_bf16(b[0], b[1]); w.w = cvt_pk_bf16(b[2], b[3]); return w; }
__device__ __forceinline__ float sum4(f32x4 a) { return (a[0] + a[1]) + (a[2] + a[3]); }
__device__ __forceinline__ float dot4(f32x4 a) { return (a[0] * a[0] + a[1] * a[1]) + (a[2] * a[2] + a[3] * a[3]); }
__device__ __forceinline__ float rsq(float x) { return 1.0f / __builtin_sqrtf(x); }
__device__ __forceinline__ float bf2f(unsigned short u) { return __builtin_bit_cast(float, (unsigned)u << 16); }
template <int X> __device__ __forceinline__ float swz_xor(float v) { return __builtin_bit_cast(float, __builtin_amdgcn_ds_swizzle(__builtin_bit_cast(int, v), (X << 10) | 0x1f)); }
__device__ __forceinline__ float xor32_sum(float s) { auto rr = __builtin_amdgcn_permlane32_swap(__float_as_uint(s), __float_as_uint(s), false, false); return __uint_as_float(rr[0]) + __uint_as_float(rr[1]); }
__device__ __forceinline__ float wave_sum(float v) { v += swz_xor<1>(v); v += swz_xor<2>(v); v += swz_xor<4>(v); v += swz_xor<8>(v); v += swz_xor<16>(v); return xor32_sum(v); }
__device__ __forceinline__ int lane_id_now() { int l; asm volatile("v_mbcnt_lo_u32_b32 %0, -1, 0\n\tv_mbcnt_hi_u32_b32 %0, -1, %0" : "=v"(l)); return l; }
#define LANE_ID() lane_id_now()
#define LDS_WAIT() asm volatile("s_waitcnt lgkmcnt(0)" ::: "memory")
#define VM_WAIT() asm volatile("s_waitcnt vmcnt(0)" ::: "memory")

#define XB_TMO      128
#define XB_XCNT(j)  (256  + 64 * (j))
#define XB_XSUB(j)  (1280 + 64 * (j))
#define XB_XGEN(j)  (2304 + 64 * (j))
#define XB_TOP      3328
#define XB_TOPGEN   3392
#define XCD_BAR_WORDS 3456
#define XB_SPIN_CAP (1u << 18)

__device__ __forceinline__ unsigned xb_ld(unsigned* p)              { return __hip_atomic_load(p, __ATOMIC_RELAXED, __HIP_MEMORY_SCOPE_AGENT); }
__device__ __forceinline__ unsigned xb_add(unsigned* p, unsigned v) { return __hip_atomic_fetch_add(p, v, __ATOMIC_RELAXED, __HIP_MEMORY_SCOPE_AGENT); }
__device__ __forceinline__ unsigned xb_xcc_id() { return (unsigned)__builtin_amdgcn_s_getreg((3 << 11) | 20) & 0xFu; }
#define XB_SPIN(cond, bar) do { unsigned _sp = 0; while (cond) { __builtin_amdgcn_s_sleep(1); \
    if ((++_sp & 255u) == 0u) { if (xb_ld(&(bar)[XB_TMO])) break; if (_sp > XB_SPIN_CAP) { atomicAdd(&(bar)[XB_TMO], 1u); break; } } } } while (0)

struct XcdBarrier { unsigned* bar; unsigned x; volatile LAS unsigned* st; };

__device__ __forceinline__ XcdBarrier xcd_barrier_post(unsigned* bar, volatile LAS unsigned* st, const int wave) {
    XcdBarrier b; b.bar = bar; b.x = xb_xcc_id(); b.st = st;
    if (wave == 0 && LANE_ID() == 0) (void)xb_add(&bar[XB_XCNT(b.x)], 1u);
    return b;
}
__device__ __forceinline__ void xcd_barrier_complete(unsigned* bar, unsigned x, unsigned& nloc, unsigned& nx) {
    const unsigned G = gridDim.x * gridDim.y * gridDim.z;
    unsigned sum, cnt, mine, sp = 0u;
    for (;;) {
        sum = 0u; cnt = 0u; mine = 0u;
#pragma unroll
        for (unsigned j = 0; j < 16; ++j) { const unsigned c = xb_ld(&bar[XB_XCNT(j)]); sum += c; cnt += (c > 0u) ? 1u : 0u; mine = (j == x) ? c : mine; }
        if (sum == G) break;
        __builtin_amdgcn_s_sleep(1);
        if ((++sp & 255u) == 0u) { if (xb_ld(&bar[XB_TMO])) break; if (sp > XB_SPIN_CAP) { atomicAdd(&bar[XB_TMO], 1u); break; } }
    }
    nloc = mine > 0u ? mine : 1u; nx = cnt > 0u ? cnt : 1u;
}
__device__ __forceinline__ void xcd_barrier(const XcdBarrier& b, const int wave) {
    asm volatile("s_waitcnt vmcnt(0)" ::: "memory");
    __syncthreads();
    if (wave == 0 && LANE_ID() == 0) {
        unsigned* bar = b.bar;
        __builtin_amdgcn_s_waitcnt(0);
        unsigned nloc = b.st[0], nx = b.st[1];
        if (nloc == 0u) { xcd_barrier_complete(bar, b.x, nloc, nx); b.st[0] = nloc; b.st[1] = nx; }
        const unsigned old = xb_add(&bar[XB_XSUB(b.x)], 1u);
        const unsigned gen = old / nloc;
        if (old + 1u == (gen + 1u) * nloc) {
            __builtin_amdgcn_fence(__ATOMIC_RELEASE, "agent");
            asm volatile("s_waitcnt vmcnt(0)" ::: "memory");
            const unsigned og = xb_add(&bar[XB_TOP], 1u);
            const unsigned tg = og / nx;
            if (og + 1u == (tg + 1u) * nx) xb_add(&bar[XB_TOPGEN], 1u);
            else XB_SPIN(xb_ld(&bar[XB_TOPGEN]) == tg, bar);
            __builtin_amdgcn_fence(__ATOMIC_ACQUIRE, "agent");
            xb_add(&bar[XB_XGEN(b.x)], 1u);
            asm volatile("s_waitcnt vmcnt(0)" ::: "memory");
        } else {
            XB_SPIN(xb_ld(&bar[XB_XGEN(b.x)]) == gen, bar);
            __builtin_amdgcn_fence(__ATOMIC_ACQUIRE, "agent");
            asm volatile("s_waitcnt vmcnt(0)" ::: "memory");
        }
    }
    __syncthreads();
}

namespace pg {
constexpr int BM = 256, BK = 64, HALF = 128, HTB = HALF * BK * 2, STAGE_BYTES = 8 * HTB;
__host__ __device__ __forceinline__ int lds_byte(int r, int c) { const int st = (r >> 4) * 2 + (c >> 5), rr = r & 15, cc = c & 31, ob = rr * 64 + cc * 2; return st * 1024 + (ob ^ (((ob >> 9) & 1) << 5)); }
__host__ __device__ __forceinline__ void stage_rc(int b, int& R, int& C) { const int st = b / 1024, sb = b % 1024, swz = sb ^ (((sb >> 9) & 1) << 5); R = (st >> 1) * 16 + swz / 64; C = (st & 1) * 32 + (swz % 64) / 2; }
__host__ __device__ __forceinline__ int perm32(int rho) { const int n = rho >> 4, i = rho & 15; return 8 * (i >> 2) + 4 * n + (i & 3); }

struct Unit { int pm, pn, e; };

__device__ __forceinline__ bool unit_of(long L, int nM, int nN, int& pm, int& pn) {
    const int nwg = nM * nN; if (L >= nwg) return false;
    int wgid = (int)L; { const int q = nwg / 8, r = nwg % 8, xcd = wgid % 8, off = wgid / 8; wgid = (xcd < r ? xcd * (q + 1) : r * (q + 1) + (xcd - r) * q) + off; }
    const int nig = 8 * nN, gid = wgid / nig, fm = gid * 8, gsz = (nM - fm) < 8 ? (nM - fm) : 8;
    pm = fm + ((wgid % nig) % gsz); pn = (wgid % nig) / gsz; return true;
}

struct SchedPlain {
    const bf16_t* A; int lda; const bf16_t* Bt; int K; int nM, nN, G, c;
    static constexpr bool GATHER = false;
    __device__ __forceinline__ bool next(int i, Unit& u) const { u.e = 0; return unit_of((long)i * G + c, nM, nN, u.pm, u.pn); }
    __device__ __forceinline__ void addrA(const Unit& u, const int (&R)[2], const int (&C)[2], const char*& base, unsigned (&v)[2][2]) const {
        base = (const char*)(A + (size_t)u.pm * BM * lda);
#pragma unroll
        for (int h = 0; h < 2; ++h)
#pragma unroll
            for (int i = 0; i < 2; ++i) v[h][i] = (unsigned)((h * HALF + R[i]) * lda + C[i]) * 2u;
    }
    __device__ __forceinline__ const char* ptrB(const Unit& u) const { return (const char*)(Bt + (size_t)u.pn * BM * K); }
};
struct SchedMoeGU {
    const bf16_t* A; const int* tok; const bf16_t* Bt; const LAS int* pfx; int nM, G, c;
    static constexpr bool GATHER = true;
    __device__ __forceinline__ int list_of(int mt) const { int l = 0;
#pragma unroll
        for (int k = 1; k < 16; ++k) l += (mt >= pfx[k]) ? 1 : 0;
        return l; }
    __device__ __forceinline__ bool next(int i, Unit& u) const { if (!unit_of((long)i * G + c, nM, 16, u.pm, u.pn)) return false; u.e = list_of(u.pm) & 7; return true; }
    __device__ __forceinline__ void addrA(const Unit& u, const int (&R)[2], const int (&C)[2], const char*& base, unsigned (&v)[2][2]) const {
        base = (const char*)A;
#pragma unroll
        for (int h = 0; h < 2; ++h)
#pragma unroll
            for (int i = 0; i < 2; ++i) { int t = tok[u.pm * BM + h * HALF + R[i]]; t = t < 0 ? 0 : t; v[h][i] = (unsigned)(t * D + C[i]) * 2u; }
    }
    __device__ __forceinline__ const char* ptrB(const Unit& u) const { return (const char*)(Bt + ((size_t)u.e * 4096 + (size_t)u.pn * BM) * D); }
};
struct SchedMoeDn {
    const bf16_t* A; const bf16_t* Bt; const LAS int* pfx; int lo, nM, G, c;
    static constexpr bool GATHER = false;
    __device__ __forceinline__ int list_of(int mt) const { int l = 0;
#pragma unroll
        for (int k = 1; k < 16; ++k) l += (mt >= pfx[k]) ? 1 : 0;
        return l; }
    __device__ __forceinline__ bool next(int i, Unit& u) const { if (!unit_of((long)i * G + c, nM, 4, u.pm, u.pn)) return false; u.pm += lo; u.e = list_of(u.pm) & 7; return true; }
    __device__ __forceinline__ void addrA(const Unit& u, const int (&R)[2], const int (&C)[2], const char*& base, unsigned (&v)[2][2]) const {
        base = (const char*)(A + (size_t)u.pm * BM * DFE);
#pragma unroll
        for (int h = 0; h < 2; ++h)
#pragma unroll
            for (int i = 0; i < 2; ++i) v[h][i] = (unsigned)((h * HALF + R[i]) * DFE + C[i]) * 2u;
    }
    __device__ __forceinline__ const char* ptrB(const Unit& u) const { return (const char*)(Bt + ((size_t)u.e * 1024 + (size_t)u.pn * BM) * DFE); }
};

template <class Epi, class Sched>
__device__ __forceinline__ void gemm_phase(LAS unsigned char* lds, const int K, const Sched& S, const Epi& E, const int wave) {
    int tid = wave * 64 + LANE_ID(); asm volatile("" : "+v"(tid));
    const int wid = wave, lane = tid & 63, wr = wid >> 2, wc = wid & 3, fr = lane & 15, fq = lane >> 4;
    int nt = K / BK; asm volatile("" : "+s"(nt));
    int R[2], C[2]; unsigned voffB[2];
#pragma unroll
    for (int i = 0; i < 2; ++i) { stage_rc(tid * 16 + i * 8192, R[i], C[i]); const int Rb = (R[i] & ~31) + perm32(R[i] & 31); voffB[i] = (unsigned)(Rb * K + C[i]) * 2u; }
    const size_t kstep = (size_t)(BK * 2);
    const size_t hstepB = (size_t)HALF * K * 2;
    const unsigned ldsw = (unsigned)wid * 1024u;
    const int aoff = lds_byte(wr * 64 + fr, fq * 8), boff = lds_byte(wc * 32 + fr, fq * 8);
#define PG_SA(b, h) (((b) * 2 + (h)) * HTB)
#define PG_SB(b, h) ((4 + (b) * 2 + (h)) * HTB)
#define PG_STAGE(bufoff, gbase, voff) do { _Pragma("unroll") for (int _i = 0; _i < 2; ++_i) \
        __builtin_amdgcn_global_load_lds((const unsigned*)((const char*)(gbase) + (voff)[_i]), (LAS unsigned*)(lds + (bufoff) + ldsw + _i * 8192), 16, 0, 0); } while (0)
#define PG_LDA(dst, b, h) do { _Pragma("unroll") for (int m = 0; m < 4; ++m) _Pragma("unroll") for (int k = 0; k < 2; ++k) dst[m][k] = *(const LAS bf16x8*)(lds + PG_SA(b, h) + aoff + m * 2048 + k * 1024); } while (0)
#define PG_LDB(dst, b, h) do { _Pragma("unroll") for (int n = 0; n < 2; ++n) _Pragma("unroll") for (int k = 0; k < 2; ++k) dst[n][k] = *(const LAS bf16x8*)(lds + PG_SB(b, h) + boff + n * 2048 + k * 1024); } while (0)
#define PG_MMA(ai, bj, At, Bt) do { __builtin_amdgcn_s_setprio(1); _Pragma("unroll") for (int m = 0; m < 4; ++m) _Pragma("unroll") for (int n = 0; n < 2; ++n) _Pragma("unroll") for (int k = 0; k < 2; ++k) \
        acc[ai][bj][m][n] = __builtin_amdgcn_mfma_f32_16x16x32_bf16(Bt[n][k], At[m][k], acc[ai][bj][m][n], 0, 0, 0); __builtin_amdgcn_s_setprio(0); } while (0)
#define PG_WAIT_V(n) asm volatile("s_waitcnt vmcnt(" #n ")" ::: "memory")
#define PG_WAIT_L(n) asm volatile("s_waitcnt lgkmcnt(" #n ")" ::: "memory")
#define PG_BAR __builtin_amdgcn_s_barrier()
#define PG_SCHED __builtin_amdgcn_sched_barrier(0)
    Unit cur, nxt; int ui = 0;
    if (!S.next(0, cur)) return;
    f32x4 acc[2][2][4][2];
#pragma unroll
    for (int a = 0; a < 2; ++a)
#pragma unroll
        for (int b = 0; b < 2; ++b)
#pragma unroll
            for (int m = 0; m < 4; ++m)
#pragma unroll
                for (int n = 0; n < 2; ++n) acc[a][b][m][n] = (f32x4){0.f, 0.f, 0.f, 0.f};
    bf16x8 At[4][2], B0[2][2], B1[2][2];
    unsigned vA[2][2], vN[2][2];
    const char* cA; S.addrA(cur, R, C, cA, vA);
    const char* cB = S.ptrB(cur);
    PG_STAGE(PG_SB(0, 0), cB, voffB); PG_STAGE(PG_SB(0, 1), cB + hstepB, voffB); PG_STAGE(PG_SA(0, 0), cA, vA[0]); PG_STAGE(PG_SA(0, 1), cA, vA[1]);
    if (wr == 1) PG_BAR;
    PG_WAIT_V(2); PG_BAR;
    PG_STAGE(PG_SB(1, 0), cB + kstep, voffB); PG_STAGE(PG_SA(1, 0), cA + kstep, vA[0]); PG_STAGE(PG_SB(1, 1), cB + hstepB + kstep, voffB);
    PG_WAIT_V(6); PG_BAR;
    for (;;) {
        const bool has_next = S.next(ui + 1, nxt);
        const char* nA = cA; const char* nB = cB;
#pragma unroll
        for (int h = 0; h < 2; ++h)
#pragma unroll
            for (int i = 0; i < 2; ++i) vN[h][i] = vA[h][i];
        if (has_next) { S.addrA(nxt, R, C, nA, vN); nB = S.ptrB(nxt); }
        for (int t = 0; t < nt; t += 2) {
            const bool last = (t == nt - 2);
            const char* a1 = cA + (size_t)(t + 1) * kstep;
            const char* a2 = last ? nA : cA + (size_t)(t + 2) * kstep; const char* b2 = last ? nB : cB + (size_t)(t + 2) * kstep;
            const char* a3 = a2 + kstep; const char* b3 = b2 + kstep;
            unsigned w0[2], w1[2];
            if constexpr (Sched::GATHER) { w0[0] = last ? vN[0][0] : vA[0][0]; w0[1] = last ? vN[0][1] : vA[0][1]; w1[0] = last ? vN[1][0] : vA[1][0]; w1[1] = last ? vN[1][1] : vA[1][1]; }
            else { w0[0] = vA[0][0]; w0[1] = vA[0][1]; w1[0] = vA[1][0]; w1[1] = vA[1][1]; }
            PG_LDB(B0, 0, 0); PG_LDB(B1, 0, 1); PG_SCHED; PG_LDA(At, 0, 0); PG_STAGE(PG_SA(1, 1), a1, vA[1]);
            PG_WAIT_V(8); PG_WAIT_L(0); PG_BAR; PG_MMA(0, 0, At, B0); PG_MMA(0, 1, At, B1); PG_BAR; PG_SCHED;
            PG_LDA(At, 0, 1); PG_STAGE(PG_SB(0, 0), b2, voffB); PG_STAGE(PG_SB(0, 1), b2 + hstepB, voffB); PG_STAGE(PG_SA(0, 0), a2, w0);
            PG_WAIT_V(8); PG_WAIT_L(0); PG_BAR; PG_MMA(1, 0, At, B0); PG_MMA(1, 1, At, B1); PG_BAR; PG_SCHED;
            PG_LDB(B0, 1, 0); PG_LDB(B1, 1, 1); PG_SCHED; PG_LDA(At, 1, 0); PG_STAGE(PG_SA(0, 1), a2, w1);
            PG_WAIT_V(8); PG_WAIT_L(0); PG_BAR; PG_MMA(0, 0, At, B0); PG_MMA(0, 1, At, B1); PG_BAR; PG_SCHED;
            PG_LDA(At, 1, 1); PG_STAGE(PG_SB(1, 0), b3, voffB); PG_STAGE(PG_SB(1, 1), b3 + hstepB, voffB); PG_STAGE(PG_SA(1, 0), a3, w0);
            PG_WAIT_V(8); PG_WAIT_L(0); PG_BAR; PG_MMA(1, 0, At, B0); PG_MMA(1, 1, At, B1); PG_BAR; PG_SCHED;
        }
        if (wr == 0) PG_BAR;
        { const int l2 = LANE_ID(); E(acc, cur, wr, wc, l2 & 15, l2 >> 4); }
        if (!has_next) break;
#pragma unroll
        for (int a = 0; a < 2; ++a)
#pragma unroll
            for (int b = 0; b < 2; ++b)
#pragma unroll
                for (int m = 0; m < 4; ++m)
#pragma unroll
                    for (int n = 0; n < 2; ++n) acc[a][b][m][n] = (f32x4){0.f, 0.f, 0.f, 0.f};
        cur = nxt; cA = nA; cB = nB; ++ui;
#pragma unroll
        for (int h = 0; h < 2; ++h)
#pragma unroll
            for (int i = 0; i < 2; ++i) vA[h][i] = vN[h][i];
        if (wr == 1) PG_BAR;
    }
    PG_WAIT_V(0);
    PG_BAR;
#undef PG_SA
#undef PG_SB
#undef PG_STAGE
#undef PG_LDA
#undef PG_LDB
#undef PG_MMA
#undef PG_WAIT_V
#undef PG_WAIT_L
#undef PG_BAR
#undef PG_SCHED
}

typedef f32x4 Acc[2][2][4][2];
#define EPI_FENCE() asm volatile("" ::: "memory")
#define EPI_BAR() do { LDS_WAIT(); __builtin_amdgcn_s_barrier(); asm volatile("" ::: "memory"); } while (0)
__device__ __forceinline__ float rstd4(const float* p, float inv_n) { return rsq(sum4(*(const f32x4*)p) * inv_n + EPS); }
__device__ __forceinline__ float fq_sum(float s) { s += swz_xor<16>(s); return xor32_sum(s); }

struct EpiCU {
    const float* ssq; bf16_t* V;
    __device__ __forceinline__ void operator()(Acc& acc, const Unit& u_, int wr, int wc, int fr, int fq) const {
        Unit u = u_; asm volatile("" : "+s"(u.pm), "+s"(u.pn), "+v"(fr), "+v"(fq));
        const int cg = wc * 32 + fq * 8;
#pragma unroll
        for (int ai = 0; ai < 2; ++ai)
#pragma unroll
            for (int m = 0; m < 4; ++m) {
                const int row = u.pm * BM + ai * HALF + wr * 64 + m * 16 + fr;
                const float rs = rstd4(ssq + (size_t)row * 4, 1.0f / D), r2 = rs * rs;
                const f32x4 v0 = acc[ai][0][m][0] * acc[ai][1][m][0] * r2, v1 = acc[ai][0][m][1] * acc[ai][1][m][1] * r2;
                *(u32x4*)(V + (size_t)row * D + u.pn * HALF + cg) = pack8(v0, v1);
            }
    }
};
struct EpiB {
    const float* ssq; const bf16_t* V; const float* cw; bf16_t* Gout;
    __device__ __forceinline__ void operator()(Acc& acc, const Unit& u_, int wr, int wc, int fr, int fq) const {
        Unit u = u_; asm volatile("" : "+s"(u.pm), "+s"(u.pn), "+v"(fr), "+v"(fq));
#pragma unroll
        for (int g = 0; g < 8; ++g) { const float rs = rstd4(ssq + (size_t)(u.pm * BM + (g >> 2) * HALF + wr * 64 + (g & 3) * 16 + fr) * 4, 1.0f / D);
#pragma unroll
            for (int bj = 0; bj < 2; ++bj)
#pragma unroll
                for (int n = 0; n < 2; ++n) acc[g >> 2][bj][g & 3][n] = acc[g >> 2][bj][g & 3][n] * rs; }
        const int colb = u.pn * BM + wc * 32 + fq * 8;
        u32x4 xv[2][3];
#define EPIB_LOAD(it, dst) do { const int g_ = (it) & 7, bj_ = (it) >> 3; const int row_ = u.pm * BM + (g_ >> 2) * HALF + wr * 64 + (g_ & 3) * 16 + fr, s_ = row_ & (SEQ - 1); \
            const bf16_t* vp_ = V + (size_t)row_ * D + colb + bj_ * HALF; const u32x4 z_ = (u32x4){0u, 0u, 0u, 0u}; \
            dst[2] = *(const u32x4*)vp_; dst[1] = s_ >= 1 ? *(const u32x4*)(vp_ - D) : z_; dst[0] = s_ >= 2 ? *(const u32x4*)(vp_ - 2 * D) : z_; } while (0)
        EPIB_LOAD(0, xv[0]);
        u32x4 wq[3];
#pragma unroll
        for (int it = 0; it < 16; ++it) {
            const int g = it & 7, bj = it >> 3, ai = g >> 2, m = g & 3, col = colb + bj * HALF;
            if (g == 0) { int colw = col; asm volatile("" : "+v"(colw));
#pragma unroll
                for (int k = 0; k < 3; ++k) wq[k] = pack8(*(const f32x4*)(cw + k * D + colw), *(const f32x4*)(cw + k * D + colw + 4));
            }
            if (it + 1 < 16) EPIB_LOAD(it + 1, xv[(it + 1) & 1]);
            EPI_FENCE();
            const u32x4 x0 = xv[it & 1][0], x1 = xv[it & 1][1], x2 = xv[it & 1][2];
            f32x4 c0, c1;
#pragma unroll
            for (int q = 0; q < 4; ++q) {
                const unsigned a0 = x0[q], a1 = x1[q], a2 = x2[q];
                const unsigned w0 = wq[0][q], w1 = wq[1][q], w2 = wq[2][q];
                const float lo = __builtin_bit_cast(float, a0 << 16) * __builtin_bit_cast(float, w0 << 16) + __builtin_bit_cast(float, a1 << 16) * __builtin_bit_cast(float, w1 << 16) + __builtin_bit_cast(float, a2 << 16) * __builtin_bit_cast(float, w2 << 16);
                const float hi = __builtin_bit_cast(float, a0 & 0xffff0000u) * __builtin_bit_cast(float, w0 & 0xffff0000u) + __builtin_bit_cast(float, a1 & 0xffff0000u) * __builtin_bit_cast(float, w1 & 0xffff0000u) + __builtin_bit_cast(float, a2 & 0xffff0000u) * __builtin_bit_cast(float, w2 & 0xffff0000u);
                if (q < 2) { c0[(q & 1) * 2] = lo; c0[(q & 1) * 2 + 1] = hi; } else { c1[(q & 1) * 2] = lo; c1[(q & 1) * 2 + 1] = hi; }
            }
            const int row = u.pm * BM + ai * HALF + wr * 64 + m * 16 + fr;
            const f32x4 g0 = acc[ai][bj][m][0] * c0, g1 = acc[ai][bj][m][1] * c1;
            *(u32x4*)(Gout + (size_t)row * D + col) = pack8(g0, g1);
        }
#undef EPIB_LOAD
    }
};
__device__ __forceinline__ void unpack8(u32x4 w, f32x4& a, f32x4& b) {
    a[0] = __builtin_bit_cast(float, w.x << 16); a[1] = __builtin_bit_cast(float, w.x & 0xffff0000u); a[2] = __builtin_bit_cast(float, w.y << 16); a[3] = __builtin_bit_cast(float, w.y & 0xffff0000u);
    b[0] = __builtin_bit_cast(float, w.z << 16); b[1] = __builtin_bit_cast(float, w.z & 0xffff0000u); b[2] = __builtin_bit_cast(float, w.w << 16); b[3] = __builtin_bit_cast(float, w.w & 0xffff0000u);
}
struct EpiRes {
    bf16_t* XB; float* ssq; LAS float* ex;
    __device__ __forceinline__ void operator()(Acc& acc, const Unit& u_, int wr, int wc, int fr, int fq) const {
        Unit u = u_; asm volatile("" : "+s"(u.pm), "+s"(u.pn), "+v"(fr), "+v"(fq));
        const size_t cb = (size_t)u.pn * BM + wc * 32 + fq * 8;
        u32x4 xb[2][2];
#define EPIR_LOAD(g, dst) do { const size_t o_ = (size_t)(u.pm * BM + ((g) >> 2) * HALF + wr * 64 + ((g) & 3) * 16 + fr) * D + cb; dst[0] = *(const u32x4*)(XB + o_); dst[1] = *(const u32x4*)(XB + o_ + HALF); } while (0)
        EPIR_LOAD(0, xb[0]);
#pragma unroll
        for (int g = 0; g < 8; ++g) {
            const int ai = g >> 2, m = g & 3, rl = ai * HALF + wr * 64 + m * 16 + fr; float ss = 0.f;
            if (g + 1 < 8) EPIR_LOAD(g + 1, xb[(g + 1) & 1]);
            EPI_FENCE();
#pragma unroll
            for (int bj = 0; bj < 2; ++bj) {
                const size_t o = (size_t)(u.pm * BM + rl) * D + cb + bj * HALF;
                f32x4 b0, b1; unpack8(xb[g & 1][bj], b0, b1);
                const f32x4 x0 = b0 + acc[ai][bj][m][0], x1 = b1 + acc[ai][bj][m][1];
                *(u32x4*)(XB + o) = pack8(x0, x1);
                ss += dot4(x0) + dot4(x1);
            }
            ss = fq_sum(ss);
            if (fq == 0) ex[rl * 4 + wc] = ss;
        }
#undef EPIR_LOAD
        EPI_BAR();
        const int tx = (wr * 4 + wc) * 64 + fq * 16 + fr;
        if (tx < 256) ssq[(size_t)(u.pm * BM + tx) * 4 + u.pn] = sum4(*(const LAS f32x4*)(ex + tx * 4));
    }
};
__device__ __forceinline__ f32x4 silu_mul(f32x4 g, f32x4 u) {
    f32x4 r;
#pragma unroll
    for (int j = 0; j < 4; ++j) r[j] = g[j] * u[j] * __builtin_amdgcn_rcpf(1.0f + __builtin_amdgcn_exp2f(-1.4426950408889634f * g[j]));
    return r;
}
template <bool MOE> struct EpiGU {
    const float* ssq; bf16_t* act; int ldc; const int* tok;
    __device__ __forceinline__ void operator()(Acc& acc, const Unit& u_, int wr, int wc, int fr, int fq) const {
        Unit u = u_; asm volatile("" : "+s"(u.pm), "+s"(u.pn), "+v"(fr), "+v"(fq));
        const int cg = wc * 32 + fq * 8;
#pragma unroll
        for (int ai = 0; ai < 2; ++ai)
#pragma unroll
            for (int m = 0; m < 4; ++m) {
                const int row = u.pm * BM + ai * HALF + wr * 64 + m * 16 + fr;
                int srow = row; if (MOE) { srow = tok[row]; srow = srow < 0 ? 0 : srow; }
                const float rs = rstd4(ssq + (size_t)srow * 4, 1.0f / D);
                const f32x4 a0 = silu_mul(acc[ai][0][m][0] * rs, acc[ai][1][m][0] * rs), a1 = silu_mul(acc[ai][0][m][1] * rs, acc[ai][1][m][1] * rs);
                *(u32x4*)(act + (size_t)row * ldc + u.pn * HALF + cg) = pack8(a0, a1);
            }
    }
};
struct EpiMoeDn {
    const int* tok; const float* wsl; bf16_t* XB; float* outf; float* ssq; LAS float* ex;
    __device__ __forceinline__ void operator()(Acc& acc, const Unit& u_, int wr, int wc, int fr, int fq) const {
        Unit u = u_; asm volatile("" : "+s"(u.pm), "+s"(u.pn), "+v"(fr), "+v"(fq));
        int tk[8]; float wv[8];
#pragma unroll
        for (int g = 0; g < 8; ++g) { const int slot = u.pm * BM + (g >> 2) * HALF + wr * 64 + (g & 3) * 16 + fr; tk[g] = tok[slot]; wv[g] = wsl[slot]; }
        const size_t cb = (size_t)u.pn * BM + wc * 32 + fq * 8;
        u32x4 xb[2][2];
#define EPIM_LOAD(g, dst) do { const size_t o_ = (size_t)(tk[g] < 0 ? 0 : tk[g]) * D + cb; dst[0] = *(const u32x4*)(XB + o_); dst[1] = *(const u32x4*)(XB + o_ + HALF); } while (0)
        EPIM_LOAD(0, xb[0]);
#pragma unroll
        for (int g = 0; g < 8; ++g) {
            const int ai = g >> 2, m = g & 3, rl = ai * HALF + wr * 64 + m * 16 + fr; float ss = 0.f;
            if (g + 1 < 8) EPIM_LOAD(g + 1, xb[(g + 1) & 1]);
            EPI_FENCE();
            if (tk[g] >= 0) {
#pragma unroll
                for (int bj = 0; bj < 2; ++bj) {
                    const size_t o = (size_t)tk[g] * D + cb + bj * HALF;
                    f32x4 b0, b1; unpack8(xb[g & 1][bj], b0, b1);
                    const f32x4 x0 = b0 + acc[ai][bj][m][0] * wv[g], x1 = b1 + acc[ai][bj][m][1] * wv[g];
                    if (outf) { *(f32x4*)(outf + o) = x0; *(f32x4*)(outf + o + 4) = x1; }
                    else *(u32x4*)(XB + o) = pack8(x0, x1);
                    if (ssq) ss += dot4(x0) + dot4(x1);
                }
            }
            if (ssq) { ss = fq_sum(ss); if (fq == 0) ex[rl * 4 + wc] = ss; }
        }
#undef EPIM_LOAD
        if (ssq) {
            EPI_BAR();
            const int tx = (wr * 4 + wc) * 64 + fq * 16 + fr;
            if (tx < 256) { const int t2 = tok[u.pm * BM + tx]; if (t2 >= 0) ssq[(size_t)t2 * 4 + u.pn] = sum4(*(const LAS f32x4*)(ex + tx * 4)); }
        }
    }
};
struct EpiDown {
    const float* ssq; bf16_t* down; float* krope; float* mssq; LAS float* ex;
    __device__ __forceinline__ void operator()(Acc& acc, const Unit& u_, int wr, int wc, int fr, int fq) const {
        Unit u = u_; asm volatile("" : "+s"(u.pm), "+s"(u.pn), "+v"(fr), "+v"(fq));
        const int cg = wc * 32 + fq * 8;
#pragma unroll
        for (int ai = 0; ai < 2; ++ai)
#pragma unroll
            for (int m = 0; m < 4; ++m) {
                const int rl = ai * HALF + wr * 64 + m * 16 + fr, row = u.pm * BM + rl;
                const float rs = rstd4(ssq + (size_t)row * 4, 1.0f / D);
#pragma unroll
                for (int bj = 0; bj < 2; ++bj) {
                    const int seg = u.pn * 2 + bj;
                    const f32x4 y0 = acc[ai][bj][m][0] * rs, y1 = acc[ai][bj][m][1] * rs;
                    const float ss = fq_sum(dot4(y0) + dot4(y1));
                    if (fq == 0) ex[(bj * 256 + rl) * 4 + wc] = ss;
                    if (seg < 5) *(u32x4*)(down + (size_t)row * DOWNP + u.pn * BM + bj * HALF + cg) = pack8(y0, y1);
                    else if (wc < 2) { *(f32x4*)(krope + (size_t)row * 64 + cg) = y0; *(f32x4*)(krope + (size_t)row * 64 + cg + 4) = y1; }
                }
            }
        EPI_BAR();
        { const int tx = (wr * 4 + wc) * 64 + fq * 16 + fr, bj = tx >> 8, rl = tx & 255; const int seg = u.pn * 2 + bj, si = seg < 3 ? seg : (seg == 5 ? 3 : seg + 1); mssq[(size_t)(u.pm * BM + rl) * 8 + si] = sum4(*(const LAS f32x4*)(ex + (bj * 256 + rl) * 4)); }
    }
};
struct EpiQ {
    const float* mssq; const float* gq; const float* cosT; const float* sinT; bf16_t* Q; LAS float* ex;
    __device__ __forceinline__ void operator()(Acc& acc, const Unit& u_, int wr, int wc, int fr, int fq) const {
        Unit u = u_; asm volatile("" : "+s"(u.pm), "+s"(u.pn), "+v"(fr), "+v"(fq));
        const int cg = wc * 32 + fq * 8;
#pragma unroll
        for (int ai = 0; ai < 2; ++ai)
#pragma unroll
            for (int m = 0; m < 4; ++m) {
                const int rl = ai * HALF + wr * 64 + m * 16 + fr, row = u.pm * BM + rl;
                const f32x4 a = *(const f32x4*)(mssq + (size_t)row * 8);
                const float rs = rsq(((a[0] + a[1]) + a[2]) * (1.0f / 384.0f) + EPS);
                float ss = 0.f;
#pragma unroll
                for (int bj = 0; bj < 2; ++bj)
#pragma unroll
                    for (int n = 0; n < 2; ++n) { acc[ai][bj][m][n] = acc[ai][bj][m][n] * rs; ss += dot4(acc[ai][bj][m][n]); }
                ss = fq_sum(ss);
                if (fq == 0) ex[rl * 4 + wc] = ss;
                if (m & 1) EPI_FENCE();
            }
        EPI_BAR();
        const f32x4 g0 = *(const f32x4*)(gq + cg), g1 = *(const f32x4*)(gq + cg + 4);
        const int i0 = wc * 16 + fq * 4;
        f32x4 gr1 = (f32x4){0.f, 0.f, 0.f, 0.f}, gr2 = gr1;
        if (wc < 2) { gr1 = *(const f32x4*)(gq + 128 + i0); gr2 = *(const f32x4*)(gq + 160 + i0); }
        f32x4 cs[2], sn[2];
#define EPIQ_LOAD(g, k) do { if (wc < 2) { const size_t r_ = (size_t)(u.pm * BM + ((g) >> 2) * HALF + wr * 64 + ((g) & 3) * 16 + fr) * 32 + i0; cs[k] = *(const f32x4*)(cosT + r_); sn[k] = *(const f32x4*)(sinT + r_); } } while (0)
        EPIQ_LOAD(0, 0);
#pragma unroll
        for (int g = 0; g < 8; ++g) {
            const int ai = g >> 2, m = g & 3, rl = ai * HALF + wr * 64 + m * 16 + fr, row = u.pm * BM + rl;
            if (g + 1 < 8) EPIQ_LOAD(g + 1, (g + 1) & 1);
            EPI_FENCE();
            const f32x4 e = *(const LAS f32x4*)(ex + rl * 4);
            const float rh = rsq(sum4(e) * (1.0f / DQK) + EPS) * QSCALE;
            bf16_t* qp = Q + (size_t)row * QPITCH + u.pn * DQK;
            *(u32x4*)(qp + cg) = pack8(acc[ai][0][m][0] * g0 * rh, acc[ai][0][m][1] * g1 * rh);
            if (wc < 2) {
                const f32x4 x1 = acc[ai][1][m][0] * gr1 * rh, x2 = acc[ai][1][m][1] * gr2 * rh;
                const f32x4 o1 = x1 * cs[g & 1] - x2 * sn[g & 1], o2 = x2 * cs[g & 1] + x1 * sn[g & 1];
                u32x2 w1, w2; w1.x = cvt_pk_bf16(o1[0], o1[1]); w1.y = cvt_pk_bf16(o1[2], o1[3]); w2.x = cvt_pk_bf16(o2[0], o2[1]); w2.y = cvt_pk_bf16(o2[2], o2[3]);
                *(u32x2*)(qp + 128 + i0) = w1; *(u32x2*)(qp + 160 + i0) = w2;
            }
        }
#undef EPIQ_LOAD
    }
};
struct EpiKV {
    const float* mssq; const float* krope; const float* gk; const float* cosT; const float* sinT; bf16_t* Kc; bf16_t* Vc; LAS float* ex;
    __device__ __forceinline__ void operator()(Acc& acc, const Unit& u_, int wr, int wc, int fr, int fq) const {
        Unit u = u_; asm volatile("" : "+s"(u.pm), "+s"(u.pn), "+v"(fr), "+v"(fq));
        const int cg = wc * 32 + fq * 8;
#pragma unroll
        for (int ai = 0; ai < 2; ++ai)
#pragma unroll
            for (int m = 0; m < 4; ++m) {
                const int rl = ai * HALF + wr * 64 + m * 16 + fr, row = u.pm * BM + rl;
                const f32x2 a = *(const f32x2*)(mssq + (size_t)row * 8 + 4);
                const float rs = rsq((a[0] + a[1]) * (1.0f / 256.0f) + EPS);
#pragma unroll
                for (int bj = 0; bj < 2; ++bj)
#pragma unroll
                    for (int n = 0; n < 2; ++n) acc[ai][bj][m][n] = acc[ai][bj][m][n] * rs;
                const float ss = fq_sum(dot4(acc[ai][0][m][0]) + dot4(acc[ai][0][m][1]));
                if (fq == 0) ex[rl * 4 + wc] = ss;
                if (m & 1) EPI_FENCE();
            }
        EPI_BAR();
        const f32x4 g0 = *(const f32x4*)(gk + cg), g1 = *(const f32x4*)(gk + cg + 4);
        const int i0 = wc * 8 + fq * 2;
        const f32x2 gr1 = *(const f32x2*)(gk + 128 + i0), gr2 = *(const f32x2*)(gk + 160 + i0);
        f32x2 kr1[2], kr2[2], cs[2], sn[2]; float rp[2];
#define EPIK_LOAD(g, k) do { const size_t r_ = (size_t)(u.pm * BM + ((g) >> 2) * HALF + wr * 64 + ((g) & 3) * 16 + fr); rp[k] = mssq[r_ * 8 + 3]; \
            kr1[k] = *(const f32x2*)(krope + r_ * 64 + i0); kr2[k] = *(const f32x2*)(krope + r_ * 64 + 32 + i0); cs[k] = *(const f32x2*)(cosT + r_ * 32 + i0); sn[k] = *(const f32x2*)(sinT + r_ * 32 + i0); } while (0)
        EPIK_LOAD(0, 0);
#pragma unroll
        for (int g = 0; g < 8; ++g) {
            const int ai = g >> 2, m = g & 3, rl = ai * HALF + wr * 64 + m * 16 + fr, row = u.pm * BM + rl;
            if (g + 1 < 8) EPIK_LOAD(g + 1, (g + 1) & 1);
            EPI_FENCE();
            const f32x4 e = *(const LAS f32x4*)(ex + rl * 4);
            const float rk = rsq((sum4(e) + rp[g & 1]) * (1.0f / DQK) + EPS);
            bf16_t* kp = Kc + (size_t)row * QPITCH + u.pn * DQK;
            *(u32x4*)(kp + cg) = pack8(acc[ai][0][m][0] * g0 * rk, acc[ai][0][m][1] * g1 * rk);
            *(u32x4*)(Vc + (size_t)row * VPITCH + u.pn * DV + cg) = pack8(acc[ai][1][m][0], acc[ai][1][m][1]);
            const f32x2 x1 = kr1[g & 1] * gr1 * rk, x2 = kr2[g & 1] * gr2 * rk;
            const f32x2 o1 = x1 * cs[g & 1] - x2 * sn[g & 1], o2 = x2 * cs[g & 1] + x1 * sn[g & 1];
            *(unsigned*)(kp + 128 + i0) = cvt_pk_bf16(o1[0], o1[1]); *(unsigned*)(kp + 160 + i0) = cvt_pk_bf16(o2[0], o2[1]);
        }
#undef EPIK_LOAD
    }
};
}

namespace att {
constexpr int KP = 400, KT = 64 * KP  , VT = 16384;
constexpr int OFF_V = 0, OFF_K = 2 * VT, OFF_WS = OFF_K + 2 * KT, BYTES = OFF_WS + 8 * 256;
constexpr float THR2 = 8.0f;
#define SBAR() __builtin_amdgcn_sched_barrier(0)
__device__ __forceinline__ int v_st(int k, int c) { const int kk = (k & ~0xC) | ((k & 4) << 1) | ((k & 8) >> 1); return ((kk >> 3) * 4 + (c >> 5)) * 512 + ((kk & 7) * 32 + (c & 31)) * 2; }
__device__ __forceinline__ int v_rd_base(int lane) { return ((lane & 3) << 3) | (((lane >> 2) & 3) << 6) | (((lane >> 4) & 1) << 5) | (((lane >> 5) & 1) << 8); }
constexpr int v_rd_off(int d0, int ks, int half) { return d0 * 512 + ks * 4096 + half * 2048; }
__device__ __forceinline__ int crow(int r, int hi) { return (r & 3) + 8 * (r >> 2) + 4 * hi; }
__device__ __forceinline__ void mask_tile(f32x16& p0, f32x16& p1, int dq) {
    const float NEG = -__builtin_inff();
#pragma unroll
    for (int r = 0; r < 16; ++r) {
        const int c = (r & 3) + 8 * (r >> 2);
        if (dq - c < 0) p0[r] = NEG;
        if (dq - c - 32 < 0) p1[r] = NEG;
    }
}
__device__ __forceinline__ void attn_unit(const bf16_t* __restrict__ Q, const bf16_t* __restrict__ K, const bf16_t* __restrict__ V, bf16_t* __restrict__ O, int b, int h, int qb, LAS unsigned char* lds, const int wave) {
    int lane = LANE_ID(); asm volatile("" : "+v"(lane));
    const int wid = wave, r32 = lane & 31, hi = lane >> 5;
    const int q0 = qb * 256, NT = (q0 + 256) / 64, qlo = q0 + wid * 32;
    const size_t tok0 = (size_t)b * SEQ;
    unsigned kg[4], vg[2];
#pragma unroll
    for (int i = 0; i < 4; ++i) { const int pc = (wid + 8 * i) * 64 + lane, key = pc / 25; int cc = pc - key * 25; cc = cc == 24 ? 0 : cc; kg[i] = (unsigned)((key & 63) * QPITCH + cc * 8) * 2u; }
#pragma unroll
    for (int i = 0; i < 2; ++i) { const int pc = (wid + 8 * i) * 64 + lane, st = pc >> 5, w = pc & 31, kk = (st >> 2) * 8 + (w >> 2), c = (st & 3) * 32 + (w & 3) * 8;
        const int k = (kk & ~0xC) | ((kk & 4) << 1) | ((kk & 8) >> 1); vg[i] = (unsigned)(k * VPITCH + c) * 2u; }
    const char* Kh = (const char*)(K + tok0 * QPITCH + h * DQK); const char* Vh = (const char*)(V + tok0 * VPITCH + h * DV);
    LAS unsigned char* Vl = lds + OFF_V; LAS unsigned char* Kl = lds + OFF_K;
    LAS float* wsf = (LAS float*)(lds + OFF_WS) + wid * 64;
#define ADMA(t, bf) do { const char* kt_ = Kh + (size_t)(t) * 64 * QPITCH * 2; const char* vt_ = Vh + (size_t)(t) * 64 * VPITCH * 2; \
        _Pragma("unroll") for (int i = 0; i < 3; ++i) __builtin_amdgcn_global_load_lds((const unsigned*)(kt_ + kg[i]), (LAS unsigned*)(Kl + (bf) * KT + (wid + 8 * i) * 1024), 16, 0, 0); \
        if (wid == 0) __builtin_amdgcn_global_load_lds((const unsigned*)(kt_ + kg[3]), (LAS unsigned*)(Kl + (bf) * KT + 24 * 1024), 16, 0, 0); \
        _Pragma("unroll") for (int i = 0; i < 2; ++i) __builtin_amdgcn_global_load_lds((const unsigned*)(vt_ + vg[i]), (LAS unsigned*)(Vl + (bf) * VT + (wid + 8 * i) * 1024), 16, 0, 0); } while (0)
    bf16x8 qr[12];
    { const bf16_t* qp = Q + (tok0 + qlo + r32) * QPITCH + h * DQK + hi * 8;
#pragma unroll
      for (int d0 = 0; d0 < 12; ++d0) qr[d0] = *(const bf16x8*)(qp + d0 * 16); }
    ADMA(0, 0);
    VM_WAIT(); __builtin_amdgcn_s_barrier(); asm volatile("" ::: "memory");
    float m_reg = -1e30f, l_reg = 0.f; f32x16 o[4];
#pragma unroll
    for (int d = 0; d < 4; ++d) o[d] = f32x16{};
    const int kfb = r32 * KP + hi * 16;
    const int vrb = (int)(uintptr_t)Vl + v_rd_base(lane);
    for (int t = 0; t < NT; ++t) {
        const int bf = t & 1;
        if (t + 1 < NT) ADMA(t + 1, bf ^ 1);
        if (64 * t <= qlo + 31) {
            f32x16 p0 = f32x16{}, p1 = f32x16{};
            { const LAS unsigned char* kb = Kl + bf * KT + kfb;
#pragma unroll
              for (int d0 = 0; d0 < 12; ++d0) {
                  const bf16x8 b0 = *(const LAS bf16x8*)(kb + d0 * 32), b1 = *(const LAS bf16x8*)(kb + 32 * KP + d0 * 32);
                  p0 = __builtin_amdgcn_mfma_f32_32x32x16_bf16(b0, qr[d0], p0, 0, 0, 0);
                  p1 = __builtin_amdgcn_mfma_f32_32x32x16_bf16(b1, qr[d0], p1, 0, 0, 0); } }
            if (64 * t + 63 > qlo) mask_tile(p0, p1, qlo + r32 - 4 * hi - 64 * t);
            float pmax = p0[0];
#pragma unroll
            for (int r = 1; r < 16; ++r) pmax = fmaxf(pmax, p0[r]);
#pragma unroll
            for (int r = 0; r < 16; ++r) pmax = fmaxf(pmax, p1[r]);
            { auto rr = __builtin_amdgcn_permlane32_swap(__float_as_uint(pmax), __float_as_uint(pmax), false, false); pmax = fmaxf(__uint_as_float(rr[0]), __uint_as_float(rr[1])); }
            float mn, alpha;
            if (__builtin_expect(__all(pmax - m_reg <= THR2), 1)) { mn = m_reg; alpha = 1.f; }
            else { mn = fmaxf(m_reg, pmax); alpha = __builtin_amdgcn_exp2f(m_reg - mn); m_reg = mn; }
            float ps = 0.f;
#pragma unroll
            for (int r = 0; r < 16; ++r) { p0[r] = __builtin_amdgcn_exp2f(p0[r] - mn); ps += p0[r]; }
#pragma unroll
            for (int r = 0; r < 16; ++r) { p1[r] = __builtin_amdgcn_exp2f(p1[r] - mn); ps += p1[r]; }
            { auto rr = __builtin_amdgcn_permlane32_swap(__float_as_uint(ps), __float_as_uint(ps), false, false); ps = __uint_as_float(rr[0]) + __uint_as_float(rr[1]); }
            l_reg = l_reg * alpha + ps;
            bf16x8 pa0, pa1, pa2, pa3;
#define PK4(P, B_, OUT) do { unsigned a0 = cvt_pk_bf16(P[B_+0], P[B_+1]), a1 = cvt_pk_bf16(P[B_+2], P[B_+3]); \
        unsigned b0 = cvt_pk_bf16(P[B_+4], P[B_+5]), b1 = cvt_pk_bf16(P[B_+6], P[B_+7]); \
        auto r0 = __builtin_amdgcn_permlane32_swap(a0, b0, false, false); auto r1 = __builtin_amdgcn_permlane32_swap(a1, b1, false, false); \
        u32x4 w = {r0[0], r1[0], r0[1], r1[1]}; OUT = __builtin_bit_cast(bf16x8, w); } while (0)
            PK4(p0, 0, pa0); PK4(p0, 8, pa1); PK4(p1, 0, pa2); PK4(p1, 8, pa3);
#undef PK4
            if (__any(alpha < 1.f)) { if (hi == 0) wsf[r32] = alpha; LDS_WAIT();
#pragma unroll
                for (int d = 0; d < 4; ++d)
#pragma unroll
                    for (int r = 0; r < 16; ++r) o[d][r] *= wsf[crow(r, hi)]; }
            const int vb0 = vrb + bf * VT;
#define TRRD(dst, off) asm volatile("ds_read_b64_tr_b16 %0, %1 offset:%2" : "=&v"(dst) : "v"(vb0), "i"(off) : "memory")
#define PV_D0(d0) do { s16x4 l0, l1, l2, l3, h0, h1, h2, h3; constexpr int b_ = v_rd_off(d0, 0, 0); \
        TRRD(l0, b_); TRRD(h0, b_ + 2048); TRRD(l1, b_ + 4096); TRRD(h1, b_ + 6144); TRRD(l2, b_ + 8192); TRRD(h2, b_ + 10240); TRRD(l3, b_ + 12288); TRRD(h3, b_ + 14336); \
        asm volatile("s_waitcnt lgkmcnt(0)" ::: "memory"); SBAR(); \
        o[d0] = __builtin_amdgcn_mfma_f32_32x32x16_bf16(pa0, (bf16x8){l0[0], l0[1], l0[2], l0[3], h0[0], h0[1], h0[2], h0[3]}, o[d0], 0, 0, 0); \
        o[d0] = __builtin_amdgcn_mfma_f32_32x32x16_bf16(pa1, (bf16x8){l1[0], l1[1], l1[2], l1[3], h1[0], h1[1], h1[2], h1[3]}, o[d0], 0, 0, 0); \
        o[d0] = __builtin_amdgcn_mfma_f32_32x32x16_bf16(pa2, (bf16x8){l2[0], l2[1], l2[2], l2[3], h2[0], h2[1], h2[2], h2[3]}, o[d0], 0, 0, 0); \
        o[d0] = __builtin_amdgcn_mfma_f32_32x32x16_bf16(pa3, (bf16x8){l3[0], l3[1], l3[2], l3[3], h3[0], h3[1], h3[2], h3[3]}, o[d0], 0, 0, 0); } while (0)
            PV_D0(0); PV_D0(1); PV_D0(2); PV_D0(3);
#undef PV_D0
#undef TRRD
        }
        LDS_WAIT(); VM_WAIT(); __builtin_amdgcn_s_barrier(); asm volatile("" ::: "memory");
    }
    if (hi == 0) wsf[32 + r32] = l_reg; LDS_WAIT();
    bf16_t* Ow = O + (tok0 + qlo) * VPITCH + h * DV;
#pragma unroll
    for (int r = 0; r < 16; ++r) { const int orow = crow(r, hi); const float rl = __builtin_amdgcn_rcpf(wsf[32 + orow]);
#pragma unroll
        for (int d = 0; d < 4; ++d) { const float v = o[d][r] * rl; const float vn = swz_xor<1>(v);
            if ((r32 & 1) == 0) *(unsigned*)(Ow + (size_t)orow * VPITCH + d * 32 + r32) = cvt_pk_bf16(v, vn); } }
    LDS_WAIT();
#undef ADMA
}
#undef SBAR
}

#ifndef PH_MASK
#define PH_MASK 0xFFFF
#endif
#define PH(k) (((PH_MASK) >> (k)) & 1)
#ifndef PROBE_SA
#define PROBE_SA 1.0f
#endif
#ifndef PROBE_A0
#define PROBE_A0 0
#define PROBE_A1 1
#define PROBE_B0 1
#define PROBE_B1 2
#endif
constexpr int NWAVES = 8;
struct Args { const void* in[22]; float* out; unsigned char* ws; };
enum { I_X = 0, I_POS, I_NMIX, I_NFFN, I_CWIN, I_CW, I_CWOUT, I_MDOWN, I_MQAN, I_MKVAN, I_MUQ, I_MUKV, I_MQN, I_MKN, I_MWO, I_FG, I_FU, I_FD, I_MR, I_MG, I_MU, I_MD };

__device__ const double INVF[32] = {
    1.0, 0.7498942093324559, 0.5623413251903491, 0.4216965034285822, 0.31622776601683794, 0.23713737056616552, 0.1778279410038923, 0.1333521432163324,
    0.1, 0.07498942093324558, 0.05623413251903491, 0.04216965034285822, 0.03162277660168379, 0.023713737056616554, 0.01778279410038923, 0.01333521432163324,
    0.01, 0.007498942093324559, 0.005623413251903491, 0.004216965034285823, 0.0031622776601683794, 0.0023713737056616554, 0.0017782794100389228, 0.001333521432163324,
    0.001, 0.0007498942093324559, 0.0005623413251903491, 0.0004216965034285823, 0.00031622776601683794, 0.00023713737056616554, 0.00017782794100389227, 0.0001333521432163324};

__device__ __forceinline__ const float* wsrc4(const float* s0, const float* s1, int kind, int n) {
    if (kind == 0) return s0 + n;
    if (kind == 1) { const int ch = (n >> 8) * 128 + (n & 127); return (((n >> 7) & 1) ? s1 : s0) + ch; }
    if (kind == 2) return n < 704 ? s0 + n : (const float*)nullptr;
    const int hh = n >> 8, c = n & 255;
    if (c < 128) return s0 + hh * DQK + c;
    if (c < 192) { const int cc = c - 128, g = cc >> 5, rr = cc & 31, q = rr >> 3, nn = (rr >> 2) & 1, i = g * 16 + q * 4; return s0 + hh * DQK + 128 + nn * 32 + i; }
    return (const float*)nullptr;
}
constexpr int TR_PITCH = 136;
__device__ __forceinline__ void tr_item64(const float* s0, const float* s1, const float* gain, bf16_t* dst, int ld, int K, int kind, LAS unsigned char* scr, int kb, int nb, int ln) {
    const int k0 = 64 * kb, n0 = 64 * nb, kq = ln >> 4, n4 = ln & 15;
    const float* colp = wsrc4(s0, s1, kind, n0 + 4 * n4);
    f32x4 v[16];
#pragma unroll
    for (int i = 0; i < 16; ++i) v[i] = colp ? *(const f32x4*)(colp + (size_t)(k0 + 4 * i + kq) * ld) : (f32x4){0.f, 0.f, 0.f, 0.f};
    if (gain) {
#pragma unroll
        for (int i = 0; i < 16; ++i) v[i] = v[i] * gain[k0 + 4 * i + kq];
    }
#pragma unroll
    for (int i = 0; i < 16; ++i) { u32x2 w; w.x = cvt_pk_bf16(v[i][0], v[i][1]); w.y = cvt_pk_bf16(v[i][2], v[i][3]); *(LAS u32x2*)(scr + (4 * i + kq) * TR_PITCH + n4 * 8) = w; }
    LDS_WAIT(); asm volatile("" ::: "memory");
    const int k8 = ln & 7, nr = ln >> 3;
#pragma unroll
    for (int jj = 0; jj < 8; ++jj) { const int n = jj * 8 + nr; const LAS unsigned short* sp = (const LAS unsigned short*)(scr + (k8 * 8) * TR_PITCH + n * 2);
        u32x4 o;
        o.x = (unsigned)sp[0 * (TR_PITCH / 2)] | ((unsigned)sp[1 * (TR_PITCH / 2)] << 16); o.y = (unsigned)sp[2 * (TR_PITCH / 2)] | ((unsigned)sp[3 * (TR_PITCH / 2)] << 16);
        o.z = (unsigned)sp[4 * (TR_PITCH / 2)] | ((unsigned)sp[5 * (TR_PITCH / 2)] << 16); o.w = (unsigned)sp[6 * (TR_PITCH / 2)] | ((unsigned)sp[7 * (TR_PITCH / 2)] << 16);
        *(u32x4*)(dst + (size_t)(n0 + n) * K + k0 + 8 * k8) = o; }
    LDS_WAIT(); asm volatile("" ::: "memory");
}

__global__ void __launch_bounds__(NWAVES * 64, 2) fwd(Args args) {
    extern __shared__ __attribute__((aligned(16))) unsigned char lds_raw[];
    LAS unsigned char* lds = (LAS unsigned char*)lds_raw;
    volatile LAS unsigned* MISC = (volatile LAS unsigned*)(lds + MISC_OFF);
    const int wave = __builtin_amdgcn_readfirstlane((int)threadIdx.x >> 6);
#define tid (wave * 64 + LANE_ID())
#define lane LANE_ID()
    const int G = gridDim.x, bx = blockIdx.x;
    const int vcu = (G % 8 == 0) ? (bx % 8) * (G / 8) + bx / 8 : bx;
    unsigned char* ws = args.ws;
    unsigned* ctl = (unsigned*)(ws + WS_CTL);
    for (int u = tid; u < (LDS_BYTES - EX_OFF) / 4; u += NWAVES * 64) ((LAS unsigned*)(lds + EX_OFF))[u] = 0u;
    __syncthreads();
    XcdBarrier bar = xcd_barrier_post(ctl + CW_BAR, MISC + 8, wave);
#ifndef PROBE
#define PROBE 0
#endif
#if PROBE
    unsigned long long* TS = (unsigned long long*)(ws + WS_CTL + 65536);
    int n_stamp = 0;
#define STAMP() do { if (bx == 0 && wave == 0 && LANE_ID() == 0) TS[n_stamp] = __builtin_amdgcn_s_memrealtime(); ++n_stamp; } while (0)
#else
#define STAMP() do { } while (0)
#endif
    STAMP();
#define GRID_BAR() do { xcd_barrier(bar, wave); STAMP(); } while (0)

    float* out = args.out; int bxl = bx; int zi = 0;
    LAS float* const EX = (LAS float*)(lds + EX_OFF);
    LAS int* const PFX = (LAS int*)(lds + TAB_OFF);
#define WSP(T_, off) ((T_*)(ws + (off)))
#define ARP(off) ((bf16_t*)(ws + WS_AR + (off)))
#define WTP(off) ((bf16_t*)(ws + WS_W + (off)))
#define INF(k) ((const float*)args.in[(k) + zi])

    for (int j = 0; j < 2; ++j) {
#define LAUNDER() do { asm volatile("" : "+s"(ws)); asm volatile("" : "+s"(out)); asm volatile("" : "+s"(bxl)); zi = 0; asm volatile("" : "+s"(zi)); } while (0)
        LAUNDER();
        if constexpr (PH(0))
        {
            int ln = LANE_ID(); asm volatile("" : "+v"(ln));
            LAS unsigned char* scr = lds + wave * 16384;
            const int gw = vcu * NWAVES + wave, NGW = G * NWAVES;
            constexpr int C_CU = 16 * 32, C_B = 16 * 16, C_OUT = 16 * 16, C_GU = 16 * 88, C_DN = 44 * 16, C_DOWN = 16 * 12, C_UQ = 6 * 32, C_UKV = 4 * 32, C_O = 16 * 16, C_MGU1 = 16 * 64, C_MDN1 = 32 * 16;
            constexpr int NIT = C_CU + C_B + C_OUT + C_GU + C_DN + C_DOWN + C_UQ + C_UKV + C_O + NE * C_MGU1 + NE * C_MDN1;
            for (int it = gw; it < NIT; it += NGW) {
                int r = it; const float* d_s0 = nullptr; const float* d_s1 = nullptr; const float* d_gain = nullptr; bf16_t* d_dst = nullptr; int d_ld = 0, d_K = 0, d_nblk = 1, d_kind = 0;
                if (r < C_CU) { const float* cwin = INF(I_CWIN) + (size_t)j * D * 3 * D; d_s0 = cwin + D; d_s1 = cwin + 2 * D; d_ld = 3 * D; d_gain = INF(I_NMIX) + (2 * j) * D; d_K = D; d_nblk = 32; d_kind = 1; d_dst = WTP(W_CU); }
                else if ((r -= C_CU) < C_B) { d_s0 = INF(I_CWIN) + (size_t)j * D * 3 * D; d_ld = 3 * D; d_gain = INF(I_NMIX) + (2 * j) * D; d_K = D; d_nblk = 16; d_dst = WTP(W_B); }
                else if ((r -= C_B) < C_OUT) { d_s0 = INF(I_CWOUT) + (size_t)j * D * D; d_ld = D; d_K = D; d_nblk = 16; d_dst = WTP(W_OUT); }
                else if ((r -= C_OUT) < C_GU) { d_s0 = INF(I_FG) + (size_t)j * D * DFF; d_s1 = INF(I_FU) + (size_t)j * D * DFF; d_ld = DFF; d_gain = INF(I_NFFN) + (2 * j) * D; d_K = D; d_nblk = 88; d_kind = 1; d_dst = WTP(W_GU); }
                else if ((r -= C_GU) < C_DN) { d_s0 = INF(I_FD) + (size_t)j * DFF * D; d_ld = D; d_K = DFF; d_nblk = 16; d_dst = WTP(W_DN); }
                else if ((r -= C_DN) < C_DOWN) { d_s0 = INF(I_MDOWN) + (size_t)j * D * 704; d_ld = 704; d_gain = INF(I_NMIX) + (2 * j + 1) * D; d_K = D; d_nblk = 12; d_kind = 2; d_dst = WTP(W_DOWN); }
                else if ((r -= C_DOWN) < C_UQ) { d_s0 = INF(I_MUQ) + (size_t)j * 384 * 1536; d_ld = 1536; d_gain = INF(I_MQAN) + j * 384; d_K = 384; d_nblk = 32; d_kind = 3; d_dst = WTP(W_UQ); }
                else if ((r -= C_UQ) < C_UKV) { d_s0 = INF(I_MUKV) + (size_t)j * 256 * 2048; d_ld = 2048; d_gain = INF(I_MKVAN) + j * 256; d_K = 256; d_nblk = 32; d_dst = WTP(W_UKV); }
                else if ((r -= C_UKV) < C_O) { d_s0 = INF(I_MWO) + (size_t)j * D * D; d_ld = D; d_K = D; d_nblk = 16; d_dst = WTP(W_O); }
                else if ((r -= C_O) < NE * C_MGU1) { const int e = r / C_MGU1; r -= e * C_MGU1; d_s0 = INF(I_MG) + ((size_t)j * NE + e) * D * DFE; d_s1 = INF(I_MU) + ((size_t)j * NE + e) * D * DFE; d_ld = DFE; d_gain = INF(I_NFFN) + (2 * j + 1) * D;
                    d_K = D; d_nblk = 64; d_kind = 1; d_dst = WTP(W_MGU) + (size_t)e * 4096 * D; }
                else { r -= NE * C_MGU1; const int e = r / C_MDN1; r -= e * C_MDN1; d_s0 = INF(I_MD) + ((size_t)j * NE + e) * DFE * D; d_ld = D; d_K = DFE; d_nblk = 16; d_dst = WTP(W_MDN) + (size_t)e * D * DFE; }
                tr_item64(d_s0, d_s1, d_gain, d_dst, d_ld, d_K, d_kind, scr, r / d_nblk, r % d_nblk, ln);
            }
            if (j == 0) {
                const int* pos = (const int*)INF(I_POS); const float* x_in = INF(I_X);
                bf16_t* XB = WSP(bf16_t, WS_XB); float* SSQ = WSP(float, WS_SSQ); float* COS = WSP(float, WS_COS); float* SIN = WSP(float, WS_SIN);
                for (int m = gw; m < T; m += NGW) {
                    const f32x4* xr = (const f32x4*)(x_in + (size_t)m * D) + ln;
                    f32x4 v[4]; float s = 0.f;
#pragma unroll
                    for (int q = 0; q < 4; ++q) { v[q] = xr[64 * q]; s += dot4(v[q]); }
                    s = wave_sum(s);
                    u32x2* o8 = (u32x2*)(XB + (size_t)m * D) + ln;
#pragma unroll
                    for (int q = 0; q < 4; ++q) { u32x2 w; w.x = cvt_pk_bf16(v[q][0], v[q][1]); w.y = cvt_pk_bf16(v[q][2], v[q][3]); o8[64 * q] = w; }
                    if (ln < 4) SSQ[(size_t)m * 4 + ln] = ln == 0 ? s : 0.f;
                    if (ln < 32) {
                        const double a = (double)pos[m] * INVF[ln];
                        const double n = __builtin_rint(a * 0.15915494309189535);
                        const float rr = (float)(a - n * 6.283185307179586);
                        COS[(size_t)m * 32 + ln] = cosf(rr); SIN[(size_t)m * 32 + ln] = sinf(rr);
                    }
                }
            }
        }
        GRID_BAR();
        LAUNDER();
        if constexpr (PH(1))
        {
            pg::SchedPlain S{WSP(bf16_t, WS_XB), D, WTP(W_CU), D, T / 256, 8, G, bxl};
            pg::EpiCU E{WSP(float, WS_SSQ), ARP(AR_V)};
            pg::gemm_phase(lds, D, S, E, wave);
        }
        GRID_BAR();
        LAUNDER();
        if constexpr (PH(2))
        {
            pg::SchedPlain S{WSP(bf16_t, WS_XB), D, WTP(W_B), D, T / 256, 4, G, bxl};
            pg::EpiB E{WSP(float, WS_SSQ), ARP(AR_V), INF(I_CW) + (size_t)j * 3 * D, ARP(AR_G)};
            pg::gemm_phase(lds, D, S, E, wave);
        }
        GRID_BAR();
        LAUNDER();
        if constexpr (PH(3))
        {
            pg::SchedPlain S{ARP(AR_G), D, WTP(W_OUT), D, T / 256, 4, G, bxl};
            pg::EpiRes E{WSP(bf16_t, WS_XB), WSP(float, WS_SSQ), EX};
            pg::gemm_phase(lds, D, S, E, wave);
        }
        GRID_BAR();
        LAUNDER();
        if constexpr (PH(4))
        {
            pg::SchedPlain S{WSP(bf16_t, WS_XB), D, WTP(W_GU), D, T / 256, 22, G, bxl};
            pg::EpiGU<false> E{WSP(float, WS_SSQ), ARP(AR_ACT), DFF, nullptr};
            pg::gemm_phase(lds, D, S, E, wave);
        }
        GRID_BAR();
        LAUNDER();
        if constexpr (PH(5))
        {
            pg::SchedPlain S{ARP(AR_ACT), DFF, WTP(W_DN), DFF, T / 256, 4, G, bxl};
            pg::EpiRes E{WSP(bf16_t, WS_XB), WSP(float, WS_SSQ), EX};
            pg::gemm_phase(lds, DFF, S, E, wave);
        }
        GRID_BAR();
        LAUNDER();
        if constexpr (PH(6))
        {
            pg::SchedPlain S{WSP(bf16_t, WS_XB), D, WTP(W_DOWN), D, T / 256, 3, G, bxl};
            pg::EpiDown E{WSP(float, WS_SSQ), ARP(AR_DOWN), WSP(float, WS_KROPE), WSP(float, WS_MSSQ), EX};
            pg::gemm_phase(lds, D, S, E, wave);
        }
        GRID_BAR();
        LAUNDER();
        if constexpr (PH(7))
        {
            pg::SchedPlain S{ARP(AR_DOWN), DOWNP, WTP(W_UQ), 384, T / 256, 8, G, bxl};
            pg::EpiQ E{WSP(float, WS_MSSQ), INF(I_MQN) + j * DQK, WSP(float, WS_COS), WSP(float, WS_SIN), ARP(AR_Q), EX};
            pg::gemm_phase(lds, 384, S, E, wave);
        }
        LAUNDER();
        if constexpr (PH(8))
        {
            pg::SchedPlain S{ARP(AR_DOWN) + 384, DOWNP, WTP(W_UKV), 256, T / 256, 8, G, bxl};
            pg::EpiKV E{WSP(float, WS_MSSQ), WSP(float, WS_KROPE), INF(I_MKN) + j * DQK, WSP(float, WS_COS), WSP(float, WS_SIN), ARP(AR_K), ARP(AR_VV), EX};
            pg::gemm_phase(lds, 256, S, E, wave);
        }
        GRID_BAR();
        LAUNDER();
        if constexpr (PH(9))
        {
            const bf16_t* Qp = ARP(AR_Q); const bf16_t* Kp = ARP(AR_K); const bf16_t* Vp = ARP(AR_VV); bf16_t* Op = ARP(AR_O);
            for (int it = vcu; it < NBATCH * NH * 4; it += G) {
                const int bh = it >> 2, pr = it & 3, b = bh >> 3, h = bh & 7;
                for (int pass = 0; pass < 2; ++pass) att::attn_unit(Qp, Kp, Vp, Op, b, h, pass == 0 ? 7 - pr : pr, lds, wave);
            }
        }
        GRID_BAR();
        LAUNDER();
        if constexpr (PH(10))
        {
            pg::SchedPlain S{ARP(AR_O), D, WTP(W_O), D, T / 256, 4, G, bxl};
            pg::EpiRes E{WSP(bf16_t, WS_XB), WSP(float, WS_SSQ), EX};
            pg::gemm_phase(lds, D, S, E, wave);
        }
        GRID_BAR();
        LAUNDER();
        if constexpr (PH(11))
        {
            int tl = wave * 64 + LANE_ID(); asm volatile("" : "+v"(tl)); const int ln = tl & 63;
            LAS float* GR = (LAS float*)lds;
            LAS int* LC = (LAS int*)(lds + 32768);
            int* ME = WSP(int, WS_ME); float* MW = WSP(float, WS_MW); int* WGCNT = WSP(int, WS_WGCNT); const bf16_t* XBr = WSP(bf16_t, WS_XB);
            const float* nffn1 = INF(I_NFFN) + (2 * j + 1) * D; const float* rt = INF(I_MR) + (size_t)j * D * NE;
            for (int i = tl; i < D * NE; i += NWAVES * 64) { const int k = i >> 3, e = i & 7; GR[e * D + k] = nffn1[k] * rt[i]; }
            for (int ch = bx; ch < T / 128; ch += G) {
                if (tl < 16) LC[tl] = 0;
                __syncthreads();
                for (int q = 0; q < 16; ++q) {
                    const int tk = ch * 128 + wave * 16 + q;
                    const u32x2* xr = (const u32x2*)(XBr + (size_t)tk * D) + ln;
                    f32x4 v[4]; float s = 0.f, lg[8];
#pragma unroll
                    for (int qq = 0; qq < 4; ++qq) { const u32x2 w = xr[64 * qq]; v[qq][0] = __builtin_bit_cast(float, w.x << 16); v[qq][1] = __builtin_bit_cast(float, w.x & 0xffff0000u); v[qq][2] = __builtin_bit_cast(float, w.y << 16); v[qq][3] = __builtin_bit_cast(float, w.y & 0xffff0000u); s += dot4(v[qq]); }
#pragma unroll
                    for (int e = 0; e < 8; ++e) { float a = 0.f;
#pragma unroll
                        for (int qq = 0; qq < 4; ++qq) { const f32x4 g = *(const LAS f32x4*)(GR + e * D + 4 * ln + 256 * qq); a += (v[qq][0] * g[0] + v[qq][1] * g[1]) + (v[qq][2] * g[2] + v[qq][3] * g[3]); }
                        lg[e] = wave_sum(a); }
                    s = wave_sum(s);
                    const float rs = rsq(s * (1.0f / D) + EPS);
                    int e1 = 0; float l1 = lg[0];
#pragma unroll
                    for (int e = 1; e < 8; ++e) if (lg[e] > l1) { l1 = lg[e]; e1 = e; }
                    int e2 = 0; float l2 = -__builtin_inff();
#pragma unroll
                    for (int e = 0; e < 8; ++e) if (e != e1 && lg[e] > l2) { l2 = lg[e]; e2 = e; }
                    const float ex = __expf((l2 - l1) * rs), w1 = 1.0f / (1.0f + ex), w2 = ex / (1.0f + ex);
                    if (ln == 0) {
                        const int r1 = atomicAdd((int*)&LC[e1], 1), r2 = atomicAdd((int*)&LC[8 + e2], 1);
                        ME[tk] = e1 | (e2 << 4) | (r1 << 8) | (r2 << 16); MW[2 * tk] = w1; MW[2 * tk + 1] = w2;
                    }
                }
                __syncthreads();
                if (tl < 16) WGCNT[ch * 16 + tl] = LC[tl];
                __syncthreads();
            }
        }
        GRID_BAR();
        LAUNDER();
        if constexpr (PH(12))
        {
            int tl = wave * 64 + LANE_ID(); asm volatile("" : "+v"(tl));
            LAS int* PART = (LAS int*)lds;
            LAS int* BASE = (LAS int*)(lds + 4096);
            LAS int* OFFS = (LAS int*)(lds + 4096 + 64);
            int* ME = WSP(int, WS_ME); float* MW = WSP(float, WS_MW); int* WGCNT = WSP(int, WS_WGCNT); int* TOK = WSP(int, WS_TOK); float* WSL = WSP(float, WS_WSL); int* TAB = WSP(int, WS_TAB);
            { const int l = tl & 15, part = tl >> 4; int s = 0;
              for (int c = 0; c < 8; ++c) s += WGCNT[(part * 8 + c) * 16 + l];
              PART[part * 16 + l] = s; }
            __syncthreads();
            if (tl < 16) { int run = 0; for (int p = 0; p < 32; ++p) { const int v = PART[p * 16 + tl]; PART[p * 16 + tl] = run; run += v; } OFFS[tl] = run; }
            __syncthreads();
            if (tl == 0) { int tp = 0; for (int l = 0; l < 16; ++l) { BASE[l] = tp * 256; PFX[l] = tp; tp += (OFFS[l] + 255) >> 8; } PFX[16] = tp;
                if (bx == 0) { for (int l = 0; l <= 16; ++l) TAB[l] = PFX[l]; } }
            __syncthreads();
            if (bx < 16) { const int l = bx, tot = OFFS[l], b0 = BASE[l], e0 = b0 + (((tot + 255) >> 8) << 8);
                for (int s = b0 + tot + tl; s < e0; s += NWAVES * 64) { TOK[s] = -1; WSL[s] = 0.f; } }
            __syncthreads();
            for (int ch = bx; ch < T / 128; ch += G) {
                if (tl < 16) { int o = BASE[tl] + PART[(ch >> 3) * 16 + tl]; for (int c = (ch & ~7); c < ch; ++c) o += WGCNT[c * 16 + tl]; OFFS[tl] = o; }
                __syncthreads();
                if (tl < 128) { const int tk = ch * 128 + tl, me = ME[tk]; const int e1 = me & 15, e2 = (me >> 4) & 15, r1 = (me >> 8) & 255, r2 = (me >> 16) & 255;
                    const int s1 = OFFS[e1] + r1, s2 = OFFS[8 + e2] + r2;
                    TOK[s1] = tk; WSL[s1] = MW[2 * tk]; TOK[s2] = tk; WSL[s2] = MW[2 * tk + 1]; }
                __syncthreads();
            }
        }
        GRID_BAR();
        if (tid <= 16) PFX[tid] = WSP(int, WS_TAB)[tid];
        __syncthreads();
        LAUNDER();
        if constexpr (PH(13))
        {
            pg::SchedMoeGU S{WSP(bf16_t, WS_XB), WSP(int, WS_TOK), WTP(W_MGU), PFX, PFX[16], G, bxl};
            pg::EpiGU<true> E{WSP(float, WS_SSQ), ARP(AR_ACT), DFE, WSP(int, WS_TOK)};
            pg::gemm_phase(lds, D, S, E, wave);
        }
        GRID_BAR();
        LAUNDER();
        if constexpr (PH(14))
        {
            pg::SchedMoeDn S{ARP(AR_ACT), WTP(W_MDN), PFX, 0, PFX[8], G, bxl};
            pg::EpiMoeDn E{WSP(int, WS_TOK), WSP(float, WS_WSL), WSP(bf16_t, WS_XB), nullptr, nullptr, EX};
            pg::gemm_phase(lds, DFE, S, E, wave);
        }
        GRID_BAR();
        LAUNDER();
        if constexpr (PH(15))
        {
            pg::SchedMoeDn S{ARP(AR_ACT), WTP(W_MDN), PFX, PFX[8], PFX[16] - PFX[8], G, bxl};
            pg::EpiMoeDn E{WSP(int, WS_TOK), WSP(float, WS_WSL), WSP(bf16_t, WS_XB), j == 0 ? nullptr : out, j == 0 ? WSP(float, WS_SSQ) : nullptr, EX};
            pg::gemm_phase(lds, DFE, S, E, wave);
        }
        if (j == 0) GRID_BAR();
    }
#if PROBE
    GRID_BAR();
    {
        float da = 0.f, db = 0.f;
        for (int i = PROBE_A0; i < PROBE_A1; ++i) da += (float)(long long)(TS[i + 1] - TS[i]) * 0.01f;
        for (int i = PROBE_B0; i < PROBE_B1; ++i) db += (float)(long long)(TS[i + 1] - TS[i]) * 0.01f;
        const float delta = __builtin_sqrtf(da * 1e-6f * PROBE_SA);
        const int tl = wave * 64 + LANE_ID();
        for (size_t i = (size_t)bx * 512 + tl; i < (size_t)T * D / 4; i += (size_t)G * 512) { f32x4 v = ((f32x4*)out)[i]; v = v * (1.0f + delta); ((f32x4*)out)[i] = v; }
        __syncthreads();
        if (bx == 0 && tl == 0) out[0] += db * 0.02f;
    }
#endif
}

#undef tid
#undef lane
extern "C" void kernel_launch(void* const* d_in, const int* in_sizes, int n_in, void* d_out, int out_size, void* d_ws, size_t ws_size, hipStream_t stream) {
    static int grid = 0;
    if (grid == 0) {
        if (n_in != 22 || out_size != T * D || ws_size < WS_END) { fprintf(stderr, "kernel_launch: unexpected shapes (n_in %d, out %d, ws %zu)\n", n_in, out_size, ws_size); grid = -1; return; }
        int dev = 0, cus = 0;
        if (hipGetDevice(&dev) != hipSuccess || hipDeviceGetAttribute(&cus, hipDeviceAttributeMultiprocessorCount, dev) != hipSuccess) { grid = -1; return; }
        if (hipFuncSetAttribute((const void*)fwd, hipFuncAttributeMaxDynamicSharedMemorySize, LDS_BYTES) != hipSuccess) { fprintf(stderr, "kernel_launch: hipFuncSetAttribute failed\n"); grid = -1; return; }
        int per_cu = 0;
        if (hipOccupancyMaxActiveBlocksPerMultiprocessor(&per_cu, (const void*)fwd, NWAVES * 64, LDS_BYTES) != hipSuccess || per_cu < 1) fprintf(stderr, "kernel_launch: occupancy query says %d\n", per_cu);
        (void)hipGetLastError();
        grid = cus;
    }
    if (grid < 0) return;
    (void)hipMemsetAsync((char*)d_ws + WS_CTL, 0, CTL_ZERO_BYTES, stream);
    Args a{};
    for (int i = 0; i < 22; ++i) a.in[i] = d_in[i];
    a.out = (float*)d_out; a.ws = (unsigned char*)d_ws;
    hipLaunchKernelGGL(fwd, dim3(grid), dim3(NWAVES * 64), LDS_BYTES, stream, a);
}
```

```cpp
#include <hip/hip_runtime.h>
#include <cstdio>
#include <cstdint>

#define LAS __attribute__((address_space(3)))
#define GAS __attribute__((address_space(1)))
typedef unsigned short bf16_t;
typedef short bf16x8 __attribute__((ext_vector_type(8)));
typedef short s16x4 __attribute__((ext_vector_type(4)));
typedef float f32x2 __attribute__((ext_vector_type(2)));
typedef float f32x4 __attribute__((ext_vector_type(4)));
typedef float f32x16 __attribute__((ext_vector_type(16)));
typedef unsigned u32x2 __attribute__((ext_vector_type(2)));
typedef unsigned u32x4 __attribute__((ext_vector_type(4)));
typedef GAS unsigned gu32;

constexpr int T = 32768, D = 1024, SEQ = 2048, NBATCH = 16, NH = 8;
constexpr int DQK = 192, DV = 128, QPITCH = NH * DQK  , VPITCH = NH * DV  ;
constexpr int DFF = 2816, DFE = 2048, NE = 8;
constexpr int DOWNP = 768;
constexpr float EPS = 1e-6f;
constexpr float QSCALE = 0.07216878364870322f * 1.4426950408889634f;
constexpr int MAXSLOT = 65536 + 16 * 256;

constexpr size_t MiB = 1u << 20;
constexpr size_t WS_CTL = 0, CTL_ZERO_BYTES = 1 * MiB;
constexpr size_t WS_SSQ = 1 * MiB;
constexpr size_t WS_MSSQ = 3 * MiB;
constexpr size_t WS_KROPE = 6 * MiB;
constexpr size_t WS_COS = 14 * MiB, WS_SIN = 18 * MiB;
constexpr size_t WS_ME = 22 * MiB;
constexpr size_t WS_MW = 22 * MiB + 256 * 1024;
constexpr size_t WS_WGCNT = 23 * MiB;
constexpr size_t WS_TAB = 23 * MiB + 64 * 1024;
constexpr size_t WS_TOK = 24 * MiB;
constexpr size_t WS_WSL = 24 * MiB + 512 * 1024;
constexpr size_t WS_XB = 26 * MiB;
constexpr size_t WS_W = 90 * MiB;
constexpr size_t W_CU = 0, W_B = 4 * MiB, W_OUT = 6 * MiB, W_GU = 8 * MiB, W_DN = 19 * MiB, W_DOWN = 25 * MiB, W_UQ = 26 * MiB + 512 * 1024,
                 W_UKV = 28 * MiB, W_O = 29 * MiB, W_MGU = 32 * MiB, W_MDN = 96 * MiB;
constexpr size_t WS_AR = 218 * MiB;
constexpr size_t AR_V = 0, AR_G = 64 * MiB;
constexpr size_t AR_ACT = 0;
constexpr size_t AR_DOWN = 0, AR_Q = 64 * MiB, AR_K = 160 * MiB, AR_VV = 256 * MiB, AR_O = 0;
constexpr size_t WS_END = 538 * MiB;

constexpr int CW_BAR = 4096;

constexpr int RING_BYTES = 131072;
constexpr int EX_OFF = RING_BYTES;
constexpr int TAB_OFF = EX_OFF + 8192;
constexpr int MISC_OFF = TAB_OFF + 256;
constexpr int LDS_BYTES = MISC_OFF + 128 + 1024;

__device__ __forceinline__ unsigned cvt_pk_bf16(float lo, float hi) { unsigned r; asm volatile("v_cvt_pk_bf16_f32 %0, %1, %2" : "=v"(r) : "v"(lo), "v"(hi)); return r; }
__device__ __forceinline__ u32x4 pack8(f32x4 a, f32x4 b) { u32x4 w; w.x = cvt_pk_bf16(a[0], a[1]); w.y = cvt_pk_bf16(a[2], a[3]); w.z = cvt_pk_bf16(b[0], b[1]); w.w = cvt_pk_bf16(b[2], b[3]); return w; }
__device__ __forceinline__ float sum4(f32x4 a) { return (a[0] + a[1]) + (a[2] + a[3]); }
__device__ __forceinline__ float dot4(f32x4 a) { return (a[0] * a[0] + a[1] * a[1]) + (a[2] * a[2] + a[3] * a[3]); }
__device__ __forceinline__ float rsq(float x) { return 1.0f / __builtin_sqrtf(x); }
__device__ __forceinline__ float bf2f(unsigned short u) { return __builtin_bit_cast(float, (unsigned)u << 16); }
template <int X> __device__ __forceinline__ float swz_xor(float v) { return __builtin_bit_cast(float, __builtin_amdgcn_ds_swizzle(__builtin_bit_cast(int, v), (X << 10) | 0x1f)); }
__device__ __forceinline__ float xor32_sum(float s) { auto rr = __builtin_amdgcn_permlane32_swap(__float_as_uint(s), __float_as_uint(s), false, false); return __uint_as_float(rr[0]) + __uint_as_float(rr[1]); }
__device__ __forceinline__ float wave_sum(float v) { v += swz_xor<1>(v); v += swz_xor<2>(v); v += swz_xor<4>(v); v += swz_xor<8>(v); v += swz_xor<16>(v); return xor32_sum(v); }
__device__ __forceinline__ int lane_id_now() { int l; asm volatile("v_mbcnt_lo_u32_b32 %0, -1, 0\n\tv_mbcnt_hi_u32_b32 %0, -1, %0" : "=v"(l)); return l; }
#define LANE_ID() lane_id_now()
#define LDS_WAIT() asm volatile("s_waitcnt lgkmcnt(0)" ::: "memory")
#define VM_WAIT() asm volatile("s_waitcnt vmcnt(0)" ::: "memory")

#define XB_TMO      128
#define XB_XCNT(j)  (256  + 64 * (j))
#define XB_XSUB(j)  (1280 + 64 * (j))
#define XB_XGEN(j)  (2304 + 64 * (j))
#define XB_TOP      3328
#define XB_TOPGEN   3392
#define XCD_BAR_WORDS 3456
#define XB_SPIN_CAP (1u << 18)

__device__ __forceinline__ unsigned xb_ld(unsigned* p)              { return __hip_atomic_load(p, __ATOMIC_RELAXED, __HIP_MEMORY_SCOPE_AGENT); }
__device__ __forceinline__ unsigned xb_add(unsigned* p, unsigned v) { return __hip_atomic_fetch_add(p, v, __ATOMIC_RELAXED, __HIP_MEMORY_SCOPE_AGENT); }
__device__ __forceinline__ unsigned xb_xcc_id() { return (unsigned)__builtin_amdgcn_s_getreg((3 << 11) | 20) & 0xFu; }
#define XB_SPIN(cond, bar) do { unsigned _sp = 0; while (cond) { __builtin_amdgcn_s_sleep(1); \
    if ((++_sp & 255u) == 0u) { if (xb_ld(&(bar)[XB_TMO])) break; if (_sp > XB_SPIN_CAP) { atomicAdd(&(bar)[XB_TMO], 1u); break; } } } } while (0)

struct XcdBarrier { unsigned* bar; unsigned x; volatile LAS unsigned* st; };

__device__ __forceinline__ XcdBarrier xcd_barrier_post(unsigned* bar, volatile LAS unsigned* st, const int wave) {
    XcdBarrier b; b.bar = bar; b.x = xb_xcc_id(); b.st = st;
    if (wave == 0 && LANE_ID() == 0) (void)xb_add(&bar[XB_XCNT(b.x)], 1u);
    return b;
}
__device__ __forceinline__ void xcd_barrier_complete(unsigned* bar, unsigned x, unsigned& nloc, unsigned& nx) {
    const unsigned G = gridDim.x * gridDim.y * gridDim.z;
    unsigned sum, cnt, mine, sp = 0u;
    for (;;) {
        sum = 0u; cnt = 0u; mine = 0u;
#pragma unroll
        for (unsigned j = 0; j < 16; ++j) { const unsigned c = xb_ld(&bar[XB_XCNT(j)]); sum += c; cnt += (c > 0u) ? 1u : 0u; mine = (j == x) ? c : mine; }
        if (sum == G) break;
        __builtin_amdgcn_s_sleep(1);
        if ((++sp & 255u) == 0u) { if (xb_ld(&bar[XB_TMO])) break; if (sp > XB_SPIN_CAP) { atomicAdd(&bar[XB_TMO], 1u); break; } }
    }
    nloc = mine > 0u ? mine : 1u; nx = cnt > 0u ? cnt : 1u;
}
__device__ __forceinline__ void xcd_barrier(const XcdBarrier& b, const int wave) {
    asm volatile("s_waitcnt vmcnt(0)" ::: "memory");
    __syncthreads();
    if (wave == 0 && LANE_ID() == 0) {
        unsigned* bar = b.bar;
        __builtin_amdgcn_s_waitcnt(0);
        unsigned nloc = b.st[0], nx = b.st[1];
        if (nloc == 0u) { xcd_barrier_complete(bar, b.x, nloc, nx); b.st[0] = nloc; b.st[1] = nx; }
        const unsigned old = xb_add(&bar[XB_XSUB(b.x)], 1u);
        const unsigned gen = old / nloc;
        if (old + 1u == (gen + 1u) * nloc) {
            __builtin_amdgcn_fence(__ATOMIC_RELEASE, "agent");
            asm volatile("s_waitcnt vmcnt(0)" ::: "memory");
            const unsigned og = xb_add(&bar[XB_TOP], 1u);
            const unsigned tg = og / nx;
            if (og + 1u == (tg + 1u) * nx) xb_add(&bar[XB_TOPGEN], 1u);
            else XB_SPIN(xb_ld(&bar[XB_TOPGEN]) == tg, bar);
            __builtin_amdgcn_fence(__ATOMIC_ACQUIRE, "agent");
            xb_add(&bar[XB_XGEN(b.x)], 1u);
            asm volatile("s_waitcnt vmcnt(0)" ::: "memory");
        } else {
            XB_SPIN(xb_ld(&bar[XB_XGEN(b.x)]) == gen, bar);
            __builtin_amdgcn_fence(__ATOMIC_ACQUIRE, "agent");
            asm volatile("s_waitcnt vmcnt(0)" ::: "memory");
        }
    }
    __syncthreads();
}

namespace pg {
constexpr int BM = 256, BK = 64, HALF = 128, HTB = HALF * BK * 2, STAGE_BYTES = 8 * HTB;
__host__ __device__ __forceinline__ int lds_byte(int r, int c) { const int st = (r >> 4) * 2 + (c >> 5), rr = r & 15, cc = c & 31, ob = rr * 64 + cc * 2; return st * 1024 + (ob ^ (((ob >> 9) & 1) << 5)); }
__host__ __device__ __forceinline__ void stage_rc(int b, int& R, int& C) { const int st = b / 1024, sb = b % 1024, swz = sb ^ (((sb >> 9) & 1) << 5); R = (st >> 1) * 16 + swz / 64; C = (st & 1) * 32 + (swz % 64) / 2; }
__host__ __device__ __forceinline__ int perm32(int rho) { const int n = rho >> 4, i = rho & 15; return 8 * (i >> 2) + 4 * n + (i & 3); }

struct Unit { int pm, pn, e; };

__device__ __forceinline__ bool unit_of(long L, int nM, int nN, int& pm, int& pn) {
    const int nwg = nM * nN; if (L >= nwg) return false;
    int wgid = (int)L; { const int q = nwg / 8, r = nwg % 8, xcd = wgid % 8, off = wgid / 8; wgid = (xcd < r ? xcd * (q + 1) : r * (q + 1) + (xcd - r) * q) + off; }
    const int nig = 8 * nN, gid = wgid / nig, fm = gid * 8, gsz = (nM - fm) < 8 ? (nM - fm) : 8;
    pm = fm + ((wgid % nig) % gsz); pn = (wgid % nig) / gsz; return true;
}

struct SchedPlain {
    const GAS bf16_t* A; int lda; const GAS bf16_t* Bt; int K; int nM, nN, G, c;
    static constexpr bool GATHER = false;
    __device__ __forceinline__ bool next(int i, Unit& u) const { u.e = 0; return unit_of((long)i * G + c, nM, nN, u.pm, u.pn); }
    __device__ __forceinline__ void addrA(const Unit& u, const int (&R)[2], const int (&C)[2], const char*& base, unsigned (&v)[2][2]) const {
        base = (const char*)(A + (size_t)u.pm * BM * lda);
#pragma unroll
        for (int h = 0; h < 2; ++h)
#pragma unroll
            for (int i = 0; i < 2; ++i) v[h][i] = (unsigned)((h * HALF + R[i]) * lda + C[i]) * 2u;
    }
    __device__ __forceinline__ const char* ptrB(const Unit& u) const { return (const char*)(Bt + (size_t)u.pn * BM * K); }
};
struct SchedMoeGU {
    const GAS bf16_t* A; const GAS int* tok; const GAS bf16_t* Bt; const LAS int* pfx; int nM, G, c;
    static constexpr bool GATHER = true;
    __device__ __forceinline__ int list_of(int mt) const { int l = 0;
#pragma unroll
        for (int k = 1; k < 16; ++k) l += (mt >= pfx[k]) ? 1 : 0;
        return l; }
    __device__ __forceinline__ bool next(int i, Unit& u) const { if (!unit_of((long)i * G + c, nM, 16, u.pm, u.pn)) return false; u.e = list_of(u.pm) & 7; return true; }
    __device__ __forceinline__ void addrA(const Unit& u, const int (&R)[2], const int (&C)[2], const char*& base, unsigned (&v)[2][2]) const {
        base = (const char*)A;
#pragma unroll
        for (int h = 0; h < 2; ++h)
#pragma unroll
            for (int i = 0; i < 2; ++i) { int t = tok[u.pm * BM + h * HALF + R[i]]; t = t < 0 ? 0 : t; v[h][i] = (unsigned)(t * D + C[i]) * 2u; }
    }
    __device__ __forceinline__ const char* ptrB(const Unit& u) const { return (const char*)(Bt + ((size_t)u.e * 4096 + (size_t)u.pn * BM) * D); }
};
struct SchedMoeDn {
    const GAS bf16_t* A; const GAS bf16_t* Bt; const LAS int* pfx; int lo, nM, G, c;
    static constexpr bool GATHER = false;
    __device__ __forceinline__ int list_of(int mt) const { int l = 0;
#pragma unroll
        for (int k = 1; k < 16; ++k) l += (mt >= pfx[k]) ? 1 : 0;
        return l; }
    __device__ __forceinline__ bool next(int i, Unit& u) const { if (!unit_of((long)i * G + c, nM, 4, u.pm, u.pn)) return false; u.pm += lo; u.e = list_of(u.pm) & 7; return true; }
    __device__ __forceinline__ void addrA(const Unit& u, const int (&R)[2], const int (&C)[2], const char*& base, unsigned (&v)[2][2]) const {
        base = (const char*)(A + (size_t)u.pm * BM * DFE);
#pragma unroll
        for (int h = 0; h < 2; ++h)
#pragma unroll
            for (int i = 0; i < 2; ++i) v[h][i] = (unsigned)((h * HALF + R[i]) * DFE + C[i]) * 2u;
    }
    __device__ __forceinline__ const char* ptrB(const Unit& u) const { return (const char*)(Bt + ((size_t)u.e * 1024 + (size_t)u.pn * BM) * DFE); }
};

template <class Epi, class Sched>
__device__ __forceinline__ void gemm_phase(LAS unsigned char* lds, const int K, const Sched& S, const Epi& E, const int wave) {
    int tid = wave * 64 + LANE_ID(); asm volatile("" : "+v"(tid));
    const int wid = wave, lane = tid & 63, wr = wid >> 2, wc = wid & 3, fr = lane & 15, fq = lane >> 4;
    int nt = K / BK; asm volatile("" : "+s"(nt));
    int R[2], C[2]; unsigned voffB[2];
#pragma unroll
    for (int i = 0; i < 2; ++i) { stage_rc(tid * 16 + i * 8192, R[i], C[i]); const int Rb = (R[i] & ~31) + perm32(R[i] & 31); voffB[i] = (unsigned)(Rb * K + C[i]) * 2u; }
    const size_t kstep = (size_t)(BK * 2);
    const size_t hstepB = (size_t)HALF * K * 2;
    const unsigned ldsw = (unsigned)wid * 1024u;
    const int aoff = lds_byte(wr * 64 + fr, fq * 8), boff = lds_byte(wc * 32 + fr, fq * 8);
#define PG_SA(b, h) (((b) * 2 + (h)) * HTB)
#define PG_SB(b, h) ((4 + (b) * 2 + (h)) * HTB)
#define PG_STAGE(bufoff, gbase, voff) do { _Pragma("unroll") for (int _i = 0; _i < 2; ++_i) \
        __builtin_amdgcn_global_load_lds((const GAS unsigned*)((const char*)(gbase) + (voff)[_i]), (LAS unsigned*)(lds + (bufoff) + ldsw + _i * 8192), 16, 0, 0); } while (0)
#define PG_LDA(dst, b, h) do { _Pragma("unroll") for (int m = 0; m < 4; ++m) _Pragma("unroll") for (int k = 0; k < 2; ++k) dst[m][k] = *(const LAS bf16x8*)(lds + PG_SA(b, h) + aoff + m * 2048 + k * 1024); } while (0)
#define PG_LDB(dst, b, h) do { _Pragma("unroll") for (int n = 0; n < 2; ++n) _Pragma("unroll") for (int k = 0; k < 2; ++k) dst[n][k] = *(const LAS bf16x8*)(lds + PG_SB(b, h) + boff + n * 2048 + k * 1024); } while (0)
#define PG_MMA(ai, bj, At, Bt) do { __builtin_amdgcn_s_setprio(1); _Pragma("unroll") for (int m = 0; m < 4; ++m) _Pragma("unroll") for (int n = 0; n < 2; ++n) _Pragma("unroll") for (int k = 0; k < 2; ++k) \
        acc[ai][bj][m][n] = __builtin_amdgcn_mfma_f32_16x16x32_bf16(Bt[n][k], At[m][k], acc[ai][bj][m][n], 0, 0, 0); __builtin_amdgcn_s_setprio(0); } while (0)
#define PG_WAIT_V(n) asm volatile("s_waitcnt vmcnt(" #n ")" ::: "memory")
#define PG_WAIT_L(n) asm volatile("s_waitcnt lgkmcnt(" #n ")" ::: "memory")
#define PG_BAR __builtin_amdgcn_s_barrier()
#define PG_SCHED __builtin_amdgcn_sched_barrier(0)
    Unit cur, nxt; int ui = 0;
    if (!S.next(0, cur)) return;
    f32x4 acc[2][2][4][2];
#pragma unroll
    for (int a = 0; a < 2; ++a)
#pragma unroll
        for (int b = 0; b < 2; ++b)
#pragma unroll
            for (int m = 0; m < 4; ++m)
#pragma unroll
                for (int n = 0; n < 2; ++n) acc[a][b][m][n] = (f32x4){0.f, 0.f, 0.f, 0.f};
    bf16x8 At[4][2], B0[2][2], B1[2][2];
    unsigned vA[2][2], vN[2][2];
    const char* cA; S.addrA(cur, R, C, cA, vA);
    const char* cB = S.ptrB(cur);
    PG_STAGE(PG_SB(0, 0), cB, voffB); PG_STAGE(PG_SB(0, 1), cB + hstepB, voffB); PG_STAGE(PG_SA(0, 0), cA, vA[0]); PG_STAGE(PG_SA(0, 1), cA, vA[1]);
    if (wr == 1) PG_BAR;
    PG_WAIT_V(2); PG_BAR;
    PG_STAGE(PG_SB(1, 0), cB + kstep, voffB); PG_STAGE(PG_SA(1, 0), cA + kstep, vA[0]); PG_STAGE(PG_SB(1, 1), cB + hstepB + kstep, voffB);
    PG_WAIT_V(6); PG_BAR;
    for (;;) {
        const bool has_next = S.next(ui + 1, nxt);
        const char* nA = cA; const char* nB = cB;
#pragma unroll
        for (int h = 0; h < 2; ++h)
#pragma unroll
            for (int i = 0; i < 2; ++i) vN[h][i] = vA[h][i];
        if (has_next) { S.addrA(nxt, R, C, nA, vN); nB = S.ptrB(nxt); }
        for (int t = 0; t < nt; t += 2) {
            const bool last = (t == nt - 2);
            const char* a1 = cA + (size_t)(t + 1) * kstep;
            const char* a2 = last ? nA : cA + (size_t)(t + 2) * kstep; const char* b2 = last ? nB : cB + (size_t)(t + 2) * kstep;
            const char* a3 = a2 + kstep; const char* b3 = b2 + kstep;
            unsigned w0[2], w1[2];
            if constexpr (Sched::GATHER) { w0[0] = last ? vN[0][0] : vA[0][0]; w0[1] = last ? vN[0][1] : vA[0][1]; w1[0] = last ? vN[1][0] : vA[1][0]; w1[1] = last ? vN[1][1] : vA[1][1]; }
            else { w0[0] = vA[0][0]; w0[1] = vA[0][1]; w1[0] = vA[1][0]; w1[1] = vA[1][1]; }
            PG_LDB(B0, 0, 0); PG_LDB(B1, 0, 1); PG_SCHED; PG_LDA(At, 0, 0); PG_STAGE(PG_SA(1, 1), a1, vA[1]);
            PG_WAIT_V(8); PG_WAIT_L(0); PG_BAR; PG_MMA(0, 0, At, B0); PG_MMA(0, 1, At, B1); PG_BAR; PG_SCHED;
            PG_LDA(At, 0, 1); PG_STAGE(PG_SB(0, 0), b2, voffB); PG_STAGE(PG_SB(0, 1), b2 + hstepB, voffB); PG_STAGE(PG_SA(0, 0), a2, w0);
            PG_WAIT_V(8); PG_WAIT_L(0); PG_BAR; PG_MMA(1, 0, At, B0); PG_MMA(1, 1, At, B1); PG_BAR; PG_SCHED;
            PG_LDB(B0, 1, 0); PG_LDB(B1, 1, 1); PG_SCHED; PG_LDA(At, 1, 0); PG_STAGE(PG_SA(0, 1), a2, w1);
            PG_WAIT_V(8); PG_WAIT_L(0); PG_BAR; PG_MMA(0, 0, At, B0); PG_MMA(0, 1, At, B1); PG_BAR; PG_SCHED;
            PG_LDA(At, 1, 1); PG_STAGE(PG_SB(1, 0), b3, voffB); PG_STAGE(PG_SB(1, 1), b3 + hstepB, voffB); PG_STAGE(PG_SA(1, 0), a3, w0);
            PG_WAIT_V(8); PG_WAIT_L(0); PG_BAR; PG_MMA(1, 0, At, B0); PG_MMA(1, 1, At, B1); PG_BAR; PG_SCHED;
        }
        if (wr == 0) PG_BAR;
        { const int l2 = LANE_ID(); E(acc, cur, wr, wc, l2 & 15, l2 >> 4); }
        if (!has_next) break;
#pragma unroll
        for (int a = 0; a < 2; ++a)
#pragma unroll
            for (int b = 0; b < 2; ++b)
#pragma unroll
                for (int m = 0; m < 4; ++m)
#pragma unroll
                    for (int n = 0; n < 2; ++n) acc[a][b][m][n] = (f32x4){0.f, 0.f, 0.f, 0.f};
        cur = nxt; cA = nA; cB = nB; ++ui;
#pragma unroll
        for (int h = 0; h < 2; ++h)
#pragma unroll
            for (int i = 0; i < 2; ++i) vA[h][i] = vN[h][i];
        if (wr == 1) PG_BAR;
    }
    PG_WAIT_V(0);
    PG_BAR;
#undef PG_SA
#undef PG_SB
#undef PG_STAGE
#undef PG_LDA
#undef PG_LDB
#undef PG_MMA
#undef PG_WAIT_V
#undef PG_WAIT_L
#undef PG_BAR
#undef PG_SCHED
}

typedef f32x4 Acc[2][2][4][2];
#define EPI_FENCE() asm volatile("" ::: "memory")
#define EPI_BAR() do { LDS_WAIT(); __builtin_amdgcn_s_barrier(); asm volatile("" ::: "memory"); } while (0)
__device__ __forceinline__ float rstd4(const GAS float* p, float inv_n) { return rsq(sum4(*(const GAS f32x4*)p) * inv_n + EPS); }
__device__ __forceinline__ float fq_sum(float s) { s += swz_xor<16>(s); return xor32_sum(s); }

struct EpiCU {
    const GAS float* ssq; GAS bf16_t* V;
    __device__ __forceinline__ void operator()(Acc& acc, const Unit& u_, int wr, int wc, int fr, int fq) const {
        Unit u = u_; asm volatile("" : "+s"(u.pm), "+s"(u.pn), "+v"(fr), "+v"(fq));
        const int cg = wc * 32 + fq * 8;
#pragma unroll
        for (int ai = 0; ai < 2; ++ai)
#pragma unroll
            for (int m = 0; m < 4; ++m) {
                const int row = u.pm * BM + ai * HALF + wr * 64 + m * 16 + fr;
                const float rs = rstd4(ssq + (size_t)row * 4, 1.0f / D), r2 = rs * rs;
                const f32x4 v0 = acc[ai][0][m][0] * acc[ai][1][m][0] * r2, v1 = acc[ai][0][m][1] * acc[ai][1][m][1] * r2;
                *(GAS u32x4*)(V + (size_t)row * D + u.pn * HALF + cg) = pack8(v0, v1);
            }
    }
};
struct EpiB {
    const GAS float* ssq; const GAS bf16_t* V; const GAS float* cw; GAS bf16_t* Gout;
    __device__ __forceinline__ void operator()(Acc& acc, const Unit& u_, int wr, int wc, int fr, int fq) const {
        Unit u = u_; asm volatile("" : "+s"(u.pm), "+s"(u.pn), "+v"(fr), "+v"(fq));
#pragma unroll
        for (int g = 0; g < 8; ++g) { const float rs = rstd4(ssq + (size_t)(u.pm * BM + (g >> 2) * HALF + wr * 64 + (g & 3) * 16 + fr) * 4, 1.0f / D);
#pragma unroll
            for (int bj = 0; bj < 2; ++bj)
#pragma unroll
                for (int n = 0; n < 2; ++n) acc[g >> 2][bj][g & 3][n] = acc[g >> 2][bj][g & 3][n] * rs; }
        const int colb = u.pn * BM + wc * 32 + fq * 8;
        u32x4 xv[2][3];
#define EPIB_LOAD(it, dst) do { const int g_ = (it) & 7, bj_ = (it) >> 3; const int row_ = u.pm * BM + (g_ >> 2) * HALF + wr * 64 + (g_ & 3) * 16 + fr, s_ = row_ & (SEQ - 1); \
            const GAS bf16_t* vp_ = V + (size_t)row_ * D + colb + bj_ * HALF; const u32x4 z_ = (u32x4){0u, 0u, 0u, 0u}; \
            dst[2] = *(const GAS u32x4*)vp_; dst[1] = s_ >= 1 ? *(const GAS u32x4*)(vp_ - D) : z_; dst[0] = s_ >= 2 ? *(const GAS u32x4*)(vp_ - 2 * D) : z_; } while (0)
        EPIB_LOAD(0, xv[0]);
        u32x4 wq[3];
#pragma unroll
        for (int it = 0; it < 16; ++it) {
            const int g = it & 7, bj = it >> 3, ai = g >> 2, m = g & 3, col = colb + bj * HALF;
            if (g == 0) { int colw = col; asm volatile("" : "+v"(colw));
#pragma unroll
                for (int k = 0; k < 3; ++k) wq[k] = pack8(*(const GAS f32x4*)(cw + k * D + colw), *(const GAS f32x4*)(cw + k * D + colw + 4));
            }
            if (it + 1 < 16) EPIB_LOAD(it + 1, xv[(it + 1) & 1]);
            EPI_FENCE();
            const u32x4 x0 = xv[it & 1][0], x1 = xv[it & 1][1], x2 = xv[it & 1][2];
            f32x4 c0, c1;
#pragma unroll
            for (int q = 0; q < 4; ++q) {
                const unsigned a0 = x0[q], a1 = x1[q], a2 = x2[q];
                const unsigned w0 = wq[0][q], w1 = wq[1][q], w2 = wq[2][q];
                const float lo = __builtin_bit_cast(float, a0 << 16) * __builtin_bit_cast(float, w0 << 16) + __builtin_bit_cast(float, a1 << 16) * __builtin_bit_cast(float, w1 << 16) + __builtin_bit_cast(float, a2 << 16) * __builtin_bit_cast(float, w2 << 16);
                const float hi = __builtin_bit_cast(float, a0 & 0xffff0000u) * __builtin_bit_cast(float, w0 & 0xffff0000u) + __builtin_bit_cast(float, a1 & 0xffff0000u) * __builtin_bit_cast(float, w1 & 0xffff0000u) + __builtin_bit_cast(float, a2 & 0xffff0000u) * __builtin_bit_cast(float, w2 & 0xffff0000u);
                if (q < 2) { c0[(q & 1) * 2] = lo; c0[(q & 1) * 2 + 1] = hi; } else { c1[(q & 1) * 2] = lo; c1[(q & 1) * 2 + 1] = hi; }
            }
            const int row = u.pm * BM + ai * HALF + wr * 64 + m * 16 + fr;
            const f32x4 g0 = acc[ai][bj][m][0] * c0, g1 = acc[ai][bj][m][1] * c1;
            *(GAS u32x4*)(Gout + (size_t)row * D + col) = pack8(g0, g1);
        }
#undef EPIB_LOAD
    }
};
__device__ __forceinline__ void unpack8(u32x4 w, f32x4& a, f32x4& b) {
    a[0] = __builtin_bit_cast(float, w.x << 16); a[1] = __builtin_bit_cast(float, w.x & 0xffff0000u); a[2] = __builtin_bit_cast(float, w.y << 16); a[3] = __builtin_bit_cast(float, w.y & 0xffff0000u);
    b[0] = __builtin_bit_cast(float, w.z << 16); b[1] = __builtin_bit_cast(float, w.z & 0xffff0000u); b[2] = __builtin_bit_cast(float, w.w << 16); b[3] = __builtin_bit_cast(float, w.w & 0xffff0000u);
}
struct EpiRes {
    GAS bf16_t* XB; GAS float* ssq; LAS float* ex;
    __device__ __forceinline__ void operator()(Acc& acc, const Unit& u_, int wr, int wc, int fr, int fq) const {
        Unit u = u_; asm volatile("" : "+s"(u.pm), "+s"(u.pn), "+v"(fr), "+v"(fq));
        const size_t cb = (size_t)u.pn * BM + wc * 32 + fq * 8;
        u32x4 xb[2][2];
#define EPIR_LOAD(g, dst) do { const size_t o_ = (size_t)(u.pm * BM + ((g) >> 2) * HALF + wr * 64 + ((g) & 3) * 16 + fr) * D + cb; dst[0] = *(const GAS u32x4*)(XB + o_); dst[1] = *(const GAS u32x4*)(XB + o_ + HALF); } while (0)
        EPIR_LOAD(0, xb[0]);
#pragma unroll
        for (int g = 0; g < 8; ++g) {
            const int ai = g >> 2, m = g & 3, rl = ai * HALF + wr * 64 + m * 16 + fr; float ss = 0.f;
            if (g + 1 < 8) EPIR_LOAD(g + 1, xb[(g + 1) & 1]);
            EPI_FENCE();
#pragma unroll
            for (int bj = 0; bj < 2; ++bj) {
                const size_t o = (size_t)(u.pm * BM + rl) * D + cb + bj * HALF;
                f32x4 b0, b1; unpack8(xb[g & 1][bj], b0, b1);
                const f32x4 x0 = b0 + acc[ai][bj][m][0], x1 = b1 + acc[ai][bj][m][1];
                *(GAS u32x4*)(XB + o) = pack8(x0, x1);
                ss += dot4(x0) + dot4(x1);
            }
            ss = fq_sum(ss);
            if (fq == 0) ex[rl * 4 + wc] = ss;
        }
#undef EPIR_LOAD
        EPI_BAR();
        const int tx = (wr * 4 + wc) * 64 + fq * 16 + fr;
        if (tx < 256) ssq[(size_t)(u.pm * BM + tx) * 4 + u.pn] = sum4(*(const LAS f32x4*)(ex + tx * 4));
    }
};
__device__ __forceinline__ f32x4 silu_mul(f32x4 g, f32x4 u) {
    f32x4 r;
#pragma unroll
    for (int j = 0; j < 4; ++j) r[j] = g[j] * u[j] * __builtin_amdgcn_rcpf(1.0f + __builtin_amdgcn_exp2f(-1.4426950408889634f * g[j]));
    return r;
}
template <bool MOE, int PMODE = 0> struct EpiGU {
    const GAS float* ssq; GAS bf16_t* act; int ldc; const GAS int* tok;
    __device__ __forceinline__ void operator()(Acc& acc, const Unit& u_, int wr, int wc, int fr, int fq) const {
        Unit u = u_; asm volatile("" : "+s"(u.pm), "+s"(u.pn), "+v"(fr), "+v"(fq));
        const int cg = wc * 32 + fq * 8;
        if (PMODE == 2 && __builtin_amdgcn_readfirstlane(__float_as_uint(acc[0][0][0][0][0])) != 0x12345678u) return;
#pragma unroll
        for (int ai = 0; ai < 2; ++ai)
#pragma unroll
            for (int m = 0; m < 4; ++m) {
                const int row = u.pm * BM + ai * HALF + wr * 64 + m * 16 + fr;
                int srow = row; if (MOE) { srow = tok[row]; srow = srow < 0 ? 0 : srow; }
                const float rs = rstd4(ssq + (size_t)srow * 4, 1.0f / D);
                const f32x4 a0 = silu_mul(acc[ai][0][m][0] * rs, acc[ai][1][m][0] * rs), a1 = silu_mul(acc[ai][0][m][1] * rs, acc[ai][1][m][1] * rs);
                if (PMODE == 1 && a0[0] != 12345.678f) continue;
                *(GAS u32x4*)(act + (size_t)row * ldc + u.pn * HALF + cg) = pack8(a0, a1);
            }
    }
};
struct EpiMoeDn {
    const GAS int* tok; const GAS float* wsl; GAS bf16_t* XB; GAS float* outf; GAS float* ssq; LAS float* ex;
    __device__ __forceinline__ void operator()(Acc& acc, const Unit& u_, int wr, int wc, int fr, int fq) const {
        Unit u = u_; asm volatile("" : "+s"(u.pm), "+s"(u.pn), "+v"(fr), "+v"(fq));
        int tk[8]; float wv[8];
#pragma unroll
        for (int g = 0; g < 8; ++g) { const int slot = u.pm * BM + (g >> 2) * HALF + wr * 64 + (g & 3) * 16 + fr; tk[g] = tok[slot]; wv[g] = wsl[slot]; }
        const size_t cb = (size_t)u.pn * BM + wc * 32 + fq * 8;
        u32x4 xb[2][2];
#define EPIM_LOAD(g, dst) do { const size_t o_ = (size_t)(tk[g] < 0 ? 0 : tk[g]) * D + cb; dst[0] = *(const GAS u32x4*)(XB + o_); dst[1] = *(const GAS u32x4*)(XB + o_ + HALF); } while (0)
        EPIM_LOAD(0, xb[0]);
#pragma unroll
        for (int g = 0; g < 8; ++g) {
            const int ai = g >> 2, m = g & 3, rl = ai * HALF + wr * 64 + m * 16 + fr; float ss = 0.f;
            if (g + 1 < 8) EPIM_LOAD(g + 1, xb[(g + 1) & 1]);
            EPI_FENCE();
            if (tk[g] >= 0) {
#pragma unroll
                for (int bj = 0; bj < 2; ++bj) {
                    const size_t o = (size_t)tk[g] * D + cb + bj * HALF;
                    f32x4 b0, b1; unpack8(xb[g & 1][bj], b0, b1);
                    const f32x4 x0 = b0 + acc[ai][bj][m][0] * wv[g], x1 = b1 + acc[ai][bj][m][1] * wv[g];
                    if (outf) { *(GAS f32x4*)(outf + o) = x0; *(GAS f32x4*)(outf + o + 4) = x1; }
                    else *(GAS u32x4*)(XB + o) = pack8(x0, x1);
                    if (ssq) ss += dot4(x0) + dot4(x1);
                }
            }
            if (ssq) { ss = fq_sum(ss); if (fq == 0) ex[rl * 4 + wc] = ss; }
        }
#undef EPIM_LOAD
        if (ssq) {
            EPI_BAR();
            const int tx = (wr * 4 + wc) * 64 + fq * 16 + fr;
            if (tx < 256) { const int t2 = tok[u.pm * BM + tx]; if (t2 >= 0) ssq[(size_t)t2 * 4 + u.pn] = sum4(*(const LAS f32x4*)(ex + tx * 4)); }
        }
    }
};
struct EpiDown {
    const GAS float* ssq; GAS bf16_t* down; GAS float* krope; GAS float* mssq; LAS float* ex;
    __device__ __forceinline__ void operator()(Acc& acc, const Unit& u_, int wr, int wc, int fr, int fq) const {
        Unit u = u_; asm volatile("" : "+s"(u.pm), "+s"(u.pn), "+v"(fr), "+v"(fq));
        const int cg = wc * 32 + fq * 8;
#pragma unroll
        for (int ai = 0; ai < 2; ++ai)
#pragma unroll
            for (int m = 0; m < 4; ++m) {
                const int rl = ai * HALF + wr * 64 + m * 16 + fr, row = u.pm * BM + rl;
                const float rs = rstd4(ssq + (size_t)row * 4, 1.0f / D);
#pragma unroll
                for (int bj = 0; bj < 2; ++bj) {
                    const int seg = u.pn * 2 + bj;
                    const f32x4 y0 = acc[ai][bj][m][0] * rs, y1 = acc[ai][bj][m][1] * rs;
                    const float ss = fq_sum(dot4(y0) + dot4(y1));
                    if (fq == 0) ex[(bj * 256 + rl) * 4 + wc] = ss;
                    if (seg < 5) *(GAS u32x4*)(down + (size_t)row * DOWNP + u.pn * BM + bj * HALF + cg) = pack8(y0, y1);
                    else if (wc < 2) { *(GAS f32x4*)(krope + (size_t)row * 64 + cg) = y0; *(GAS f32x4*)(krope + (size_t)row * 64 + cg + 4) = y1; }
                }
            }
        EPI_BAR();
        { const int tx = (wr * 4 + wc) * 64 + fq * 16 + fr, bj = tx >> 8, rl = tx & 255; const int seg = u.pn * 2 + bj, si = seg < 3 ? seg : (seg == 5 ? 3 : seg + 1); mssq[(size_t)(u.pm * BM + rl) * 8 + si] = sum4(*(const LAS f32x4*)(ex + (bj * 256 + rl) * 4)); }
    }
};
template <int PMODE = 0> struct EpiQ {
    const GAS float* mssq; const GAS float* gq; const GAS float* cosT; const GAS float* sinT; GAS bf16_t* Q; LAS float* ex;
    __device__ __forceinline__ void operator()(Acc& acc, const Unit& u_, int wr, int wc, int fr, int fq) const {
        Unit u = u_; asm volatile("" : "+s"(u.pm), "+s"(u.pn), "+v"(fr), "+v"(fq));
        if (PMODE == 2 && __builtin_amdgcn_readfirstlane(__float_as_uint(acc[0][0][0][0][0])) != 0x12345678u) return;
        const int cg = wc * 32 + fq * 8;
#pragma unroll
        for (int ai = 0; ai < 2; ++ai)
#pragma unroll
            for (int m = 0; m < 4; ++m) {
                const int rl = ai * HALF + wr * 64 + m * 16 + fr, row = u.pm * BM + rl;
                const f32x4 a = *(const GAS f32x4*)(mssq + (size_t)row * 8);
                const float rs = rsq(((a[0] + a[1]) + a[2]) * (1.0f / 384.0f) + EPS);
                float ss = 0.f;
#pragma unroll
                for (int bj = 0; bj < 2; ++bj)
#pragma unroll
                    for (int n = 0; n < 2; ++n) { acc[ai][bj][m][n] = acc[ai][bj][m][n] * rs; ss += dot4(acc[ai][bj][m][n]); }
                ss = fq_sum(ss);
                if (fq == 0) ex[rl * 4 + wc] = ss;
                if (m & 1) EPI_FENCE();
            }
        EPI_BAR();
        const f32x4 g0 = *(const GAS f32x4*)(gq + cg), g1 = *(const GAS f32x4*)(gq + cg + 4);
        const int i0 = wc * 16 + fq * 4;
        f32x4 gr1 = (f32x4){0.f, 0.f, 0.f, 0.f}, gr2 = gr1;
        if (wc < 2) { gr1 = *(const GAS f32x4*)(gq + 128 + i0); gr2 = *(const GAS f32x4*)(gq + 160 + i0); }
        f32x4 cs[2], sn[2];
#define EPIQ_LOAD(g, k) do { if (wc < 2) { const size_t r_ = (size_t)(u.pm * BM + ((g) >> 2) * HALF + wr * 64 + ((g) & 3) * 16 + fr) * 32 + i0; cs[k] = *(const GAS f32x4*)(cosT + r_); sn[k] = *(const GAS f32x4*)(sinT + r_); } } while (0)
        EPIQ_LOAD(0, 0);
#pragma unroll
        for (int g = 0; g < 8; ++g) {
            const int ai = g >> 2, m = g & 3, rl = ai * HALF + wr * 64 + m * 16 + fr, row = u.pm * BM + rl;
            if (g + 1 < 8) EPIQ_LOAD(g + 1, (g + 1) & 1);
            EPI_FENCE();
            const f32x4 e = *(const LAS f32x4*)(ex + rl * 4);
            const float rh = rsq(sum4(e) * (1.0f / DQK) + EPS) * QSCALE;
            GAS bf16_t* qp = Q + (size_t)row * QPITCH + u.pn * DQK;
            *(GAS u32x4*)(qp + cg) = pack8(acc[ai][0][m][0] * g0 * rh, acc[ai][0][m][1] * g1 * rh);
            if (wc < 2) {
                const f32x4 x1 = acc[ai][1][m][0] * gr1 * rh, x2 = acc[ai][1][m][1] * gr2 * rh;
                const f32x4 o1 = x1 * cs[g & 1] - x2 * sn[g & 1], o2 = x2 * cs[g & 1] + x1 * sn[g & 1];
                u32x2 w1, w2; w1.x = cvt_pk_bf16(o1[0], o1[1]); w1.y = cvt_pk_bf16(o1[2], o1[3]); w2.x = cvt_pk_bf16(o2[0], o2[1]); w2.y = cvt_pk_bf16(o2[2], o2[3]);
                *(GAS u32x2*)(qp + 128 + i0) = w1; *(GAS u32x2*)(qp + 160 + i0) = w2;
            }
        }
#undef EPIQ_LOAD
    }
};
struct EpiKV {
    const GAS float* mssq; const GAS float* krope; const GAS float* gk; const GAS float* cosT; const GAS float* sinT; GAS bf16_t* Kc; GAS bf16_t* Vc; LAS float* ex;
    __device__ __forceinline__ void operator()(Acc& acc, const Unit& u_, int wr, int wc, int fr, int fq) const {
        Unit u = u_; asm volatile("" : "+s"(u.pm), "+s"(u.pn), "+v"(fr), "+v"(fq));
        const int cg = wc * 32 + fq * 8;
#pragma unroll
        for (int ai = 0; ai < 2; ++ai)
#pragma unroll
            for (int m = 0; m < 4; ++m) {
                const int rl = ai * HALF + wr * 64 + m * 16 + fr, row = u.pm * BM + rl;
                const f32x2 a = *(const GAS f32x2*)(mssq + (size_t)row * 8 + 4);
                const float rs = rsq((a[0] + a[1]) * (1.0f / 256.0f) + EPS);
#pragma unroll
                for (int bj = 0; bj < 2; ++bj)
#pragma unroll
                    for (int n = 0; n < 2; ++n) acc[ai][bj][m][n] = acc[ai][bj][m][n] * rs;
                const float ss = fq_sum(dot4(acc[ai][0][m][0]) + dot4(acc[ai][0][m][1]));
                if (fq == 0) ex[rl * 4 + wc] = ss;
                if (m & 1) EPI_FENCE();
            }
        EPI_BAR();
        const f32x4 g0 = *(const GAS f32x4*)(gk + cg), g1 = *(const GAS f32x4*)(gk + cg + 4);
        const int i0 = wc * 8 + fq * 2;
        const f32x2 gr1 = *(const GAS f32x2*)(gk + 128 + i0), gr2 = *(const GAS f32x2*)(gk + 160 + i0);
        f32x2 kr1[2], kr2[2], cs[2], sn[2]; float rp[2];
#define EPIK_LOAD(g, k) do { const size_t r_ = (size_t)(u.pm * BM + ((g) >> 2) * HALF + wr * 64 + ((g) & 3) * 16 + fr); rp[k] = mssq[r_ * 8 + 3]; \
            kr1[k] = *(const GAS f32x2*)(krope + r_ * 64 + i0); kr2[k] = *(const GAS f32x2*)(krope + r_ * 64 + 32 + i0); cs[k] = *(const GAS f32x2*)(cosT + r_ * 32 + i0); sn[k] = *(const GAS f32x2*)(sinT + r_ * 32 + i0); } while (0)
        EPIK_LOAD(0, 0);
#pragma unroll
        for (int g = 0; g < 8; ++g) {
            const int ai = g >> 2, m = g & 3, rl = ai * HALF + wr * 64 + m * 16 + fr, row = u.pm * BM + rl;
            if (g + 1 < 8) EPIK_LOAD(g + 1, (g + 1) & 1);
            EPI_FENCE();
            const f32x4 e = *(const LAS f32x4*)(ex + rl * 4);
            const float rk = rsq((sum4(e) + rp[g & 1]) * (1.0f / DQK) + EPS);
            GAS bf16_t* kp = Kc + (size_t)row * QPITCH + u.pn * DQK;
            *(GAS u32x4*)(kp + cg) = pack8(acc[ai][0][m][0] * g0 * rk, acc[ai][0][m][1] * g1 * rk);
            *(GAS u32x4*)(Vc + (size_t)row * VPITCH + u.pn * DV + cg) = pack8(acc[ai][1][m][0], acc[ai][1][m][1]);
            const f32x2 x1 = kr1[g & 1] * gr1 * rk, x2 = kr2[g & 1] * gr2 * rk;
            const f32x2 o1 = x1 * cs[g & 1] - x2 * sn[g & 1], o2 = x2 * cs[g & 1] + x1 * sn[g & 1];
            *(GAS unsigned*)(kp + 128 + i0) = cvt_pk_bf16(o1[0], o1[1]); *(GAS unsigned*)(kp + 160 + i0) = cvt_pk_bf16(o2[0], o2[1]);
        }
#undef EPIK_LOAD
    }
};
}

namespace att {
constexpr int KP = 400, KT = 64 * KP  , VT = 16384;
constexpr int OFF_V = 0, OFF_K = 2 * VT, OFF_WS = OFF_K + 2 * KT, BYTES = OFF_WS + 8 * 256;
constexpr float THR2 = 8.0f;
#define SBAR() __builtin_amdgcn_sched_barrier(0)
__device__ __forceinline__ int v_st(int k, int c) { const int kk = (k & ~0xC) | ((k & 4) << 1) | ((k & 8) >> 1); return ((kk >> 3) * 4 + (c >> 5)) * 512 + ((kk & 7) * 32 + (c & 31)) * 2; }
__device__ __forceinline__ int v_rd_base(int lane) { return ((lane & 3) << 3) | (((lane >> 2) & 3) << 6) | (((lane >> 4) & 1) << 5) | (((lane >> 5) & 1) << 8); }
constexpr int v_rd_off(int d0, int ks, int half) { return d0 * 512 + ks * 4096 + half * 2048; }
__device__ __forceinline__ int crow(int r, int hi) { return (r & 3) + 8 * (r >> 2) + 4 * hi; }
__device__ __forceinline__ void mask_tile(f32x16& p0, f32x16& p1, int dq) {
    const float NEG = -__builtin_inff();
#pragma unroll
    for (int r = 0; r < 16; ++r) {
        const int c = (r & 3) + 8 * (r >> 2);
        if (dq - c < 0) p0[r] = NEG;
        if (dq - c - 32 < 0) p1[r] = NEG;
    }
}
__device__ __forceinline__ void attn_unit(const GAS bf16_t* __restrict__ Q, const GAS bf16_t* __restrict__ K, const GAS bf16_t* __restrict__ V, GAS bf16_t* __restrict__ O, int b, int h, int qb, LAS unsigned char* lds, const int wave) {
    int lane = LANE_ID(); asm volatile("" : "+v"(lane));
    const int wid = wave, r32 = lane & 31, hi = lane >> 5;
    const int q0 = qb * 256, NT = (q0 + 256) / 64, qlo = q0 + wid * 32;
    const size_t tok0 = (size_t)b * SEQ;
    unsigned kg[4], vg[2];
#pragma unroll
    for (int i = 0; i < 4; ++i) { const int pc = (wid + 8 * i) * 64 + lane, key = pc / 25; int cc = pc - key * 25; cc = cc == 24 ? 0 : cc; kg[i] = (unsigned)((key & 63) * QPITCH + cc * 8) * 2u; }
#pragma unroll
    for (int i = 0; i < 2; ++i) { const int pc = (wid + 8 * i) * 64 + lane, st = pc >> 5, w = pc & 31, kk = (st >> 2) * 8 + (w >> 2), c = (st & 3) * 32 + (w & 3) * 8;
        const int k = (kk & ~0xC) | ((kk & 4) << 1) | ((kk & 8) >> 1); vg[i] = (unsigned)(k * VPITCH + c) * 2u; }
    const char* Kh = (const char*)(K + tok0 * QPITCH + h * DQK); const char* Vh = (const char*)(V + tok0 * VPITCH + h * DV);
    LAS unsigned char* Vl = lds + OFF_V; LAS unsigned char* Kl = lds + OFF_K;
    LAS float* wsf = (LAS float*)(lds + OFF_WS) + wid * 64;
#define ADMA(t, bf) do { const char* kt_ = Kh + (size_t)(t) * 64 * QPITCH * 2; const char* vt_ = Vh + (size_t)(t) * 64 * VPITCH * 2; \
        _Pragma("unroll") for (int i = 0; i < 3; ++i) __builtin_amdgcn_global_load_lds((const GAS unsigned*)(kt_ + kg[i]), (LAS unsigned*)(Kl + (bf) * KT + (wid + 8 * i) * 1024), 16, 0, 0); \
        if (wid == 0) __builtin_amdgcn_global_load_lds((const GAS unsigned*)(kt_ + kg[3]), (LAS unsigned*)(Kl + (bf) * KT + 24 * 1024), 16, 0, 0); \
        _Pragma("unroll") for (int i = 0; i < 2; ++i) __builtin_amdgcn_global_load_lds((const GAS unsigned*)(vt_ + vg[i]), (LAS unsigned*)(Vl + (bf) * VT + (wid + 8 * i) * 1024), 16, 0, 0); } while (0)
    bf16x8 qr[12];
    { const GAS bf16_t* qp = Q + (tok0 + qlo + r32) * QPITCH + h * DQK + hi * 8;
#pragma unroll
      for (int d0 = 0; d0 < 12; ++d0) qr[d0] = *(const GAS bf16x8*)(qp + d0 * 16); }
    ADMA(0, 0);
    VM_WAIT(); __builtin_amdgcn_s_barrier(); asm volatile("" ::: "memory");
    float m_reg = -1e30f, l_reg = 0.f; f32x16 o[4];
#pragma unroll
    for (int d = 0; d < 4; ++d) o[d] = f32x16{};
    const int kfb = r32 * KP + hi * 16;
    const int vrb = (int)(uintptr_t)Vl + v_rd_base(lane);
    for (int t = 0; t < NT; ++t) {
        const int bf = t & 1;
        if (t + 1 < NT) ADMA(t + 1, bf ^ 1);
        if (64 * t <= qlo + 31) {
            f32x16 p0 = f32x16{}, p1 = f32x16{};
            { const LAS unsigned char* kb = Kl + bf * KT + kfb;
#pragma unroll
              for (int d0 = 0; d0 < 12; ++d0) {
                  const bf16x8 b0 = *(const LAS bf16x8*)(kb + d0 * 32), b1 = *(const LAS bf16x8*)(kb + 32 * KP + d0 * 32);
                  p0 = __builtin_amdgcn_mfma_f32_32x32x16_bf16(b0, qr[d0], p0, 0, 0, 0);
                  p1 = __builtin_amdgcn_mfma_f32_32x32x16_bf16(b1, qr[d0], p1, 0, 0, 0); } }
            if (64 * t + 63 > qlo) mask_tile(p0, p1, qlo + r32 - 4 * hi - 64 * t);
            float pmax = p0[0];
#pragma unroll
            for (int r = 1; r < 16; ++r) pmax = fmaxf(pmax, p0[r]);
#pragma unroll
            for (int r = 0; r < 16; ++r) pmax = fmaxf(pmax, p1[r]);
            { auto rr = __builtin_amdgcn_permlane32_swap(__float_as_uint(pmax), __float_as_uint(pmax), false, false); pmax = fmaxf(__uint_as_float(rr[0]), __uint_as_float(rr[1])); }
            float mn, alpha;
            if (__builtin_expect(__all(pmax - m_reg <= THR2), 1)) { mn = m_reg; alpha = 1.f; }
            else { mn = fmaxf(m_reg, pmax); alpha = __builtin_amdgcn_exp2f(m_reg - mn); m_reg = mn; }
            float ps = 0.f;
#pragma unroll
            for (int r = 0; r < 16; ++r) { p0[r] = __builtin_amdgcn_exp2f(p0[r] - mn); ps += p0[r]; }
#pragma unroll
            for (int r = 0; r < 16; ++r) { p1[r] = __builtin_amdgcn_exp2f(p1[r] - mn); ps += p1[r]; }
            { auto rr = __builtin_amdgcn_permlane32_swap(__float_as_uint(ps), __float_as_uint(ps), false, false); ps = __uint_as_float(rr[0]) + __uint_as_float(rr[1]); }
            l_reg = l_reg * alpha + ps;
            bf16x8 pa0, pa1, pa2, pa3;
#define PK4(P, B_, OUT) do { unsigned a0 = cvt_pk_bf16(P[B_+0], P[B_+1]), a1 = cvt_pk_bf16(P[B_+2], P[B_+3]); \
        unsigned b0 = cvt_pk_bf16(P[B_+4], P[B_+5]), b1 = cvt_pk_bf16(P[B_+6], P[B_+7]); \
        auto r0 = __builtin_amdgcn_permlane32_swap(a0, b0, false, false); auto r1 = __builtin_amdgcn_permlane32_swap(a1, b1, false, false); \
        u32x4 w = {r0[0], r1[0], r0[1], r1[1]}; OUT = __builtin_bit_cast(bf16x8, w); } while (0)
            PK4(p0, 0, pa0); PK4(p0, 8, pa1); PK4(p1, 0, pa2); PK4(p1, 8, pa3);
#undef PK4
            if (__any(alpha < 1.f)) { if (hi == 0) wsf[r32] = alpha; LDS_WAIT();
#pragma unroll
                for (int d = 0; d < 4; ++d)
#pragma unroll
                    for (int r = 0; r < 16; ++r) o[d][r] *= wsf[crow(r, hi)]; }
            const int vb0 = vrb + bf * VT;
#define TRRD(dst, off) asm volatile("ds_read_b64_tr_b16 %0, %1 offset:%2" : "=&v"(dst) : "v"(vb0), "i"(off) : "memory")
#define PV_D0(d0) do { s16x4 l0, l1, l2, l3, h0, h1, h2, h3; constexpr int b_ = v_rd_off(d0, 0, 0); \
        TRRD(l0, b_); TRRD(h0, b_ + 2048); TRRD(l1, b_ + 4096); TRRD(h1, b_ + 6144); TRRD(l2, b_ + 8192); TRRD(h2, b_ + 10240); TRRD(l3, b_ + 12288); TRRD(h3, b_ + 14336); \
        asm volatile("s_waitcnt lgkmcnt(0)" ::: "memory"); SBAR(); \
        o[d0] = __builtin_amdgcn_mfma_f32_32x32x16_bf16(pa0, (bf16x8){l0[0], l0[1], l0[2], l0[3], h0[0], h0[1], h0[2], h0[3]}, o[d0], 0, 0, 0); \
        o[d0] = __builtin_amdgcn_mfma_f32_32x32x16_bf16(pa1, (bf16x8){l1[0], l1[1], l1[2], l1[3], h1[0], h1[1], h1[2], h1[3]}, o[d0], 0, 0, 0); \
        o[d0] = __builtin_amdgcn_mfma_f32_32x32x16_bf16(pa2, (bf16x8){l2[0], l2[1], l2[2], l2[3], h2[0], h2[1], h2[2], h2[3]}, o[d0], 0, 0, 0); \
        o[d0] = __builtin_amdgcn_mfma_f32_32x32x16_bf16(pa3, (bf16x8){l3[0], l3[1], l3[2], l3[3], h3[0], h3[1], h3[2], h3[3]}, o[d0], 0, 0, 0); } while (0)
            PV_D0(0); PV_D0(1); PV_D0(2); PV_D0(3);
#undef PV_D0
#undef TRRD
        }
        LDS_WAIT(); VM_WAIT(); __builtin_amdgcn_s_barrier(); asm volatile("" ::: "memory");
    }
    if (hi == 0) wsf[32 + r32] = l_reg; LDS_WAIT();
    GAS bf16_t* Ow = O + (tok0 + qlo) * VPITCH + h * DV;
#pragma unroll
    for (int r = 0; r < 16; ++r) { const int orow = crow(r, hi); const float rl = __builtin_amdgcn_rcpf(wsf[32 + orow]);
#pragma unroll
        for (int d = 0; d < 4; ++d) { const float v = o[d][r] * rl; const float vn = swz_xor<1>(v);
            if ((r32 & 1) == 0) *(GAS unsigned*)(Ow + (size_t)orow * VPITCH + d * 32 + r32) = cvt_pk_bf16(v, vn); } }
    LDS_WAIT();
#undef ADMA
}
#undef SBAR
}

#ifndef PH_MASK
#define PH_MASK 0xFFFF
#endif
#define PH(k) (((PH_MASK) >> (k)) & 1)
#ifndef PROBE_SA
#define PROBE_SA 1.0f
#endif
#ifndef PROBE_A0
#define PROBE_A0 0
#define PROBE_A1 1
#define PROBE_B0 1
#define PROBE_B1 2
#endif
constexpr int NWAVES = 8;
struct Args { const void* in[22]; float* out; unsigned char* ws; };
enum { I_X = 0, I_POS, I_NMIX, I_NFFN, I_CWIN, I_CW, I_CWOUT, I_MDOWN, I_MQAN, I_MKVAN, I_MUQ, I_MUKV, I_MQN, I_MKN, I_MWO, I_FG, I_FU, I_FD, I_MR, I_MG, I_MU, I_MD };

__device__ const double INVF[32] = {
    1.0, 0.7498942093324559, 0.5623413251903491, 0.4216965034285822, 0.31622776601683794, 0.23713737056616552, 0.1778279410038923, 0.1333521432163324,
    0.1, 0.07498942093324558, 0.05623413251903491, 0.04216965034285822, 0.03162277660168379, 0.023713737056616554, 0.01778279410038923, 0.01333521432163324,
    0.01, 0.007498942093324559, 0.005623413251903491, 0.004216965034285823, 0.0031622776601683794, 0.0023713737056616554, 0.0017782794100389228, 0.001333521432163324,
    0.001, 0.0007498942093324559, 0.0005623413251903491, 0.0004216965034285823, 0.00031622776601683794, 0.00023713737056616554, 0.00017782794100389227, 0.0001333521432163324};

__device__ __forceinline__ const GAS float* wsrc4(const GAS float* s0, const GAS float* s1, int kind, int n) {
    if (kind == 0) return s0 + n;
    if (kind == 1) { const int ch = (n >> 8) * 128 + (n & 127); return (((n >> 7) & 1) ? s1 : s0) + ch; }
    if (kind == 2) return n < 704 ? s0 + n : (const GAS float*)nullptr;
    const int hh = n >> 8, c = n & 255;
    if (c < 128) return s0 + hh * DQK + c;
    if (c < 192) { const int cc = c - 128, g = cc >> 5, rr = cc & 31, q = rr >> 3, nn = (rr >> 2) & 1, i = g * 16 + q * 4; return s0 + hh * DQK + 128 + nn * 32 + i; }
    return (const GAS float*)nullptr;
}
constexpr int TR_PITCH = 136;
__device__ __forceinline__ void tr_item64(const GAS float* s0, const GAS float* s1, const GAS float* gain, GAS bf16_t* dst, int ld, int K, int kind, LAS unsigned char* scr, int kb, int nb, int ln) {
    const int k0 = 64 * kb, n0 = 64 * nb, kq = ln >> 4, n4 = ln & 15;
    const GAS float* colp = wsrc4(s0, s1, kind, n0 + 4 * n4);
    f32x4 v[16];
#pragma unroll
    for (int i = 0; i < 16; ++i) v[i] = colp ? *(const GAS f32x4*)(colp + (size_t)(k0 + 4 * i + kq) * ld) : (f32x4){0.f, 0.f, 0.f, 0.f};
    if (gain) {
#pragma unroll
        for (int i = 0; i < 16; ++i) v[i] = v[i] * gain[k0 + 4 * i + kq];
    }
#pragma unroll
    for (int i = 0; i < 16; ++i) { u32x2 w; w.x = cvt_pk_bf16(v[i][0], v[i][1]); w.y = cvt_pk_bf16(v[i][2], v[i][3]); *(LAS u32x2*)(scr + (4 * i + kq) * TR_PITCH + n4 * 8) = w; }
    LDS_WAIT(); asm volatile("" ::: "memory");
    const int k8 = ln & 7, nr = ln >> 3;
#pragma unroll
    for (int jj = 0; jj < 8; ++jj) { const int n = jj * 8 + nr; const LAS unsigned short* sp = (const LAS unsigned short*)(scr + (k8 * 8) * TR_PITCH + n * 2);
        u32x4 o;
        o.x = (unsigned)sp[0 * (TR_PITCH / 2)] | ((unsigned)sp[1 * (TR_PITCH / 2)] << 16); o.y = (unsigned)sp[2 * (TR_PITCH / 2)] | ((unsigned)sp[3 * (TR_PITCH / 2)] << 16);
        o.z = (unsigned)sp[4 * (TR_PITCH / 2)] | ((unsigned)sp[5 * (TR_PITCH / 2)] << 16); o.w = (unsigned)sp[6 * (TR_PITCH / 2)] | ((unsigned)sp[7 * (TR_PITCH / 2)] << 16);
        *(GAS u32x4*)(dst + (size_t)(n0 + n) * K + k0 + 8 * k8) = o; }
    LDS_WAIT(); asm volatile("" ::: "memory");
}

__global__ void __launch_bounds__(NWAVES * 64, 2) fwd(Args args) {
    extern __shared__ __attribute__((aligned(16))) unsigned char lds_raw[];
    LAS unsigned char* lds = (LAS unsigned char*)lds_raw;
    volatile LAS unsigned* MISC = (volatile LAS unsigned*)(lds + MISC_OFF);
    const int wave = __builtin_amdgcn_readfirstlane((int)threadIdx.x >> 6);
#define tid (wave * 64 + LANE_ID())
#define lane LANE_ID()
    const int G = gridDim.x, bx = blockIdx.x;
    const int vcu = (G % 8 == 0) ? (bx % 8) * (G / 8) + bx / 8 : bx;
    unsigned char* ws = args.ws;
    unsigned* ctl = (unsigned*)(ws + WS_CTL);
    for (int u = tid; u < (LDS_BYTES - EX_OFF) / 4; u += NWAVES * 64) ((LAS unsigned*)(lds + EX_OFF))[u] = 0u;
    __syncthreads();
    XcdBarrier bar = xcd_barrier_post(ctl + CW_BAR, MISC + 8, wave);
#ifndef PROBE
#define PROBE 0
#endif
#if PROBE
    unsigned long long* TS = (unsigned long long*)(ws + WS_CTL + 65536);
    int n_stamp = 0;
#define STAMP() do { if (bx == 0 && wave == 0 && LANE_ID() == 0) TS[n_stamp] = __builtin_amdgcn_s_memrealtime(); ++n_stamp; } while (0)
#else
#define STAMP() do { } while (0)
#endif
    STAMP();
#define GRID_BAR() do { xcd_barrier(bar, wave); STAMP(); } while (0)

    GAS float* out = (GAS float*)args.out; int bxl = bx; int zi = 0;
    LAS float* const EX = (LAS float*)(lds + EX_OFF);
    LAS int* const PFX = (LAS int*)(lds + TAB_OFF);
#define WSP(T_, off) ((GAS T_*)(ws + (off)))
#define ARP(off) ((GAS bf16_t*)(ws + WS_AR + (off)))
#define WTP(off) ((GAS bf16_t*)(ws + WS_W + (off)))
#define INF(k) ((const GAS float*)args.in[(k) + zi])

    for (int j = 0; j < 2; ++j) {
#define LAUNDER() do { asm volatile("" : "+s"(ws)); asm volatile("" : "+s"(out)); asm volatile("" : "+s"(bxl)); zi = 0; asm volatile("" : "+s"(zi)); } while (0)
        LAUNDER();
        if constexpr (PH(0))
        {
            int ln = LANE_ID(); asm volatile("" : "+v"(ln));
            LAS unsigned char* scr = lds + wave * 16384;
            const int gw = vcu * NWAVES + wave, NGW = G * NWAVES;
            constexpr int C_CU = 16 * 32, C_B = 16 * 16, C_OUT = 16 * 16, C_GU = 16 * 88, C_DN = 44 * 16, C_DOWN = 16 * 12, C_UQ = 6 * 32, C_UKV = 4 * 32, C_O = 16 * 16, C_MGU1 = 16 * 64, C_MDN1 = 32 * 16;
            constexpr int NIT = C_CU + C_B + C_OUT + C_GU + C_DN + C_DOWN + C_UQ + C_UKV + C_O + NE * C_MGU1 + NE * C_MDN1;
            for (int it = gw; it < NIT; it += NGW) {
                int r = it; const GAS float* d_s0 = nullptr; const GAS float* d_s1 = nullptr; const GAS float* d_gain = nullptr; GAS bf16_t* d_dst = nullptr; int d_ld = 0, d_K = 0, d_nblk = 1, d_kind = 0;
                if (r < C_CU) { const GAS float* cwin = INF(I_CWIN) + (size_t)j * D * 3 * D; d_s0 = cwin + D; d_s1 = cwin + 2 * D; d_ld = 3 * D; d_gain = INF(I_NMIX) + (2 * j) * D; d_K = D; d_nblk = 32; d_kind = 1; d_dst = WTP(W_CU); }
                else if ((r -= C_CU) < C_B) { d_s0 = INF(I_CWIN) + (size_t)j * D * 3 * D; d_ld = 3 * D; d_gain = INF(I_NMIX) + (2 * j) * D; d_K = D; d_nblk = 16; d_dst = WTP(W_B); }
                else if ((r -= C_B) < C_OUT) { d_s0 = INF(I_CWOUT) + (size_t)j * D * D; d_ld = D; d_K = D; d_nblk = 16; d_dst = WTP(W_OUT); }
                else if ((r -= C_OUT) < C_GU) { d_s0 = INF(I_FG) + (size_t)j * D * DFF; d_s1 = INF(I_FU) + (size_t)j * D * DFF; d_ld = DFF; d_gain = INF(I_NFFN) + (2 * j) * D; d_K = D; d_nblk = 88; d_kind = 1; d_dst = WTP(W_GU); }
                else if ((r -= C_GU) < C_DN) { d_s0 = INF(I_FD) + (size_t)j * DFF * D; d_ld = D; d_K = DFF; d_nblk = 16; d_dst = WTP(W_DN); }
                else if ((r -= C_DN) < C_DOWN) { d_s0 = INF(I_MDOWN) + (size_t)j * D * 704; d_ld = 704; d_gain = INF(I_NMIX) + (2 * j + 1) * D; d_K = D; d_nblk = 12; d_kind = 2; d_dst = WTP(W_DOWN); }
                else if ((r -= C_DOWN) < C_UQ) { d_s0 = INF(I_MUQ) + (size_t)j * 384 * 1536; d_ld = 1536; d_gain = INF(I_MQAN) + j * 384; d_K = 384; d_nblk = 32; d_kind = 3; d_dst = WTP(W_UQ); }
                else if ((r -= C_UQ) < C_UKV) { d_s0 = INF(I_MUKV) + (size_t)j * 256 * 2048; d_ld = 2048; d_gain = INF(I_MKVAN) + j * 256; d_K = 256; d_nblk = 32; d_dst = WTP(W_UKV); }
                else if ((r -= C_UKV) < C_O) { d_s0 = INF(I_MWO) + (size_t)j * D * D; d_ld = D; d_K = D; d_nblk = 16; d_dst = WTP(W_O); }
                else if ((r -= C_O) < NE * C_MGU1) { const int e = r / C_MGU1; r -= e * C_MGU1; d_s0 = INF(I_MG) + ((size_t)j * NE + e) * D * DFE; d_s1 = INF(I_MU) + ((size_t)j * NE + e) * D * DFE; d_ld = DFE; d_gain = INF(I_NFFN) + (2 * j + 1) * D;
                    d_K = D; d_nblk = 64; d_kind = 1; d_dst = WTP(W_MGU) + (size_t)e * 4096 * D; }
                else { r -= NE * C_MGU1; const int e = r / C_MDN1; r -= e * C_MDN1; d_s0 = INF(I_MD) + ((size_t)j * NE + e) * DFE * D; d_ld = D; d_K = DFE; d_nblk = 16; d_dst = WTP(W_MDN) + (size_t)e * D * DFE; }
                tr_item64(d_s0, d_s1, d_gain, d_dst, d_ld, d_K, d_kind, scr, r / d_nblk, r % d_nblk, ln);
            }
            if (j == 0) {
                const GAS int* pos = (const GAS int*)INF(I_POS); const GAS float* x_in = INF(I_X);
                GAS bf16_t* XB = WSP(bf16_t, WS_XB); GAS float* SSQ = WSP(float, WS_SSQ); GAS float* COS = WSP(float, WS_COS); GAS float* SIN = WSP(float, WS_SIN);
                for (int m = gw; m < T; m += NGW) {
                    const GAS f32x4* xr = (const GAS f32x4*)(x_in + (size_t)m * D) + ln;
                    f32x4 v[4]; float s = 0.f;
#pragma unroll
                    for (int q = 0; q < 4; ++q) { v[q] = xr[64 * q]; s += dot4(v[q]); }
                    s = wave_sum(s);
                    GAS u32x2* o8 = (GAS u32x2*)(XB + (size_t)m * D) + ln;
#pragma unroll
                    for (int q = 0; q < 4; ++q) { u32x2 w; w.x = cvt_pk_bf16(v[q][0], v[q][1]); w.y = cvt_pk_bf16(v[q][2], v[q][3]); o8[64 * q] = w; }
                    if (ln < 4) SSQ[(size_t)m * 4 + ln] = ln == 0 ? s : 0.f;
                    if (ln < 32) {
                        const double a = (double)pos[m] * INVF[ln];
                        const double n = __builtin_rint(a * 0.15915494309189535);
                        const float rr = (float)(a - n * 6.283185307179586);
                        COS[(size_t)m * 32 + ln] = cosf(rr); SIN[(size_t)m * 32 + ln] = sinf(rr);
                    }
                }
            }
        }
        GRID_BAR();
        LAUNDER();
        if constexpr (PH(1))
        {
            pg::SchedPlain S{WSP(bf16_t, WS_XB), D, WTP(W_CU), D, T / 256, 8, G, bxl};
            pg::EpiCU E{WSP(float, WS_SSQ), ARP(AR_V)};
            pg::gemm_phase(lds, D, S, E, wave);
        }
        GRID_BAR();
        LAUNDER();
        if constexpr (PH(2))
        {
            pg::SchedPlain S{WSP(bf16_t, WS_XB), D, WTP(W_B), D, T / 256, 4, G, bxl};
            pg::EpiB E{WSP(float, WS_SSQ), ARP(AR_V), INF(I_CW) + (size_t)j * 3 * D, ARP(AR_G)};
            pg::gemm_phase(lds, D, S, E, wave);
        }
        GRID_BAR();
        LAUNDER();
        if constexpr (PH(3))
        {
            pg::SchedPlain S{ARP(AR_G), D, WTP(W_OUT), D, T / 256, 4, G, bxl};
            pg::EpiRes E{WSP(bf16_t, WS_XB), WSP(float, WS_SSQ), EX};
            pg::gemm_phase(lds, D, S, E, wave);
        }
        GRID_BAR();
        LAUNDER();
        if constexpr (PH(4))
        {
            pg::SchedPlain S{WSP(bf16_t, WS_XB), D, WTP(W_GU), D, T / 256, 22, G, bxl};
            pg::EpiGU<false> E{WSP(float, WS_SSQ), ARP(AR_ACT), DFF, nullptr};
            pg::gemm_phase(lds, D, S, E, wave);
        }
        GRID_BAR();
#if PROBE >= 3
        {
            pg::SchedPlain S{WSP(bf16_t, WS_XB), D, WTP(W_GU), D, T / 256, 22, G, bxl};
            pg::EpiGU<false, PROBE - 3> E{WSP(float, WS_SSQ), ARP(180 * MiB), DFF, nullptr};
            pg::gemm_phase(lds, D, S, E, wave);
        }
        GRID_BAR();
#endif
        LAUNDER();
        if constexpr (PH(5))
        {
            pg::SchedPlain S{ARP(AR_ACT), DFF, WTP(W_DN), DFF, T / 256, 4, G, bxl};
            pg::EpiRes E{WSP(bf16_t, WS_XB), WSP(float, WS_SSQ), EX};
            pg::gemm_phase(lds, DFF, S, E, wave);
        }
        GRID_BAR();
        LAUNDER();
        if constexpr (PH(6))
        {
            pg::SchedPlain S{WSP(bf16_t, WS_XB), D, WTP(W_DOWN), D, T / 256, 3, G, bxl};
            pg::EpiDown E{WSP(float, WS_SSQ), ARP(AR_DOWN), WSP(float, WS_KROPE), WSP(float, WS_MSSQ), EX};
            pg::gemm_phase(lds, D, S, E, wave);
        }
        GRID_BAR();
        LAUNDER();
        if constexpr (PH(7))
        {
            pg::SchedPlain S{ARP(AR_DOWN), DOWNP, WTP(W_UQ), 384, T / 256, 8, G, bxl};
            pg::EpiQ<0> E{WSP(float, WS_MSSQ), INF(I_MQN) + j * DQK, WSP(float, WS_COS), WSP(float, WS_SIN), ARP(AR_Q), EX};
            pg::gemm_phase(lds, 384, S, E, wave);
        }
#if PROBE == 2 || PROBE == 6
        GRID_BAR();
#endif
#if PROBE == 6
        {
            pg::SchedPlain S{ARP(AR_DOWN), DOWNP, WTP(W_UQ), 384, T / 256, 8, G, bxl};
            pg::EpiQ<2> E{WSP(float, WS_MSSQ), INF(I_MQN) + j * DQK, WSP(float, WS_COS), WSP(float, WS_SIN), ARP(AR_Q), EX};
            pg::gemm_phase(lds, 384, S, E, wave);
        }
        GRID_BAR();
#endif
        LAUNDER();
        if constexpr (PH(8))
        {
            pg::SchedPlain S{ARP(AR_DOWN) + 384, DOWNP, WTP(W_UKV), 256, T / 256, 8, G, bxl};
            pg::EpiKV E{WSP(float, WS_MSSQ), WSP(float, WS_KROPE), INF(I_MKN) + j * DQK, WSP(float, WS_COS), WSP(float, WS_SIN), ARP(AR_K), ARP(AR_VV), EX};
            pg::gemm_phase(lds, 256, S, E, wave);
        }
        GRID_BAR();
        LAUNDER();
        if constexpr (PH(9))
        {
            const GAS bf16_t* Qp = ARP(AR_Q); const GAS bf16_t* Kp = ARP(AR_K); const GAS bf16_t* Vp = ARP(AR_VV); GAS bf16_t* Op = ARP(AR_O);
            for (int it = vcu; it < NBATCH * NH * 4; it += G) {
                const int bh = it >> 2, pr = it & 3, b = bh >> 3, h = bh & 7;
                for (int pass = 0; pass < 2; ++pass) att::attn_unit(Qp, Kp, Vp, Op, b, h, pass == 0 ? 7 - pr : pr, lds, wave);
            }
        }
        GRID_BAR();
        LAUNDER();
        if constexpr (PH(10))
        {
            pg::SchedPlain S{ARP(AR_O), D, WTP(W_O), D, T / 256, 4, G, bxl};
            pg::EpiRes E{WSP(bf16_t, WS_XB), WSP(float, WS_SSQ), EX};
            pg::gemm_phase(lds, D, S, E, wave);
        }
        GRID_BAR();
        LAUNDER();
        if constexpr (PH(11))
        {
            int tl = wave * 64 + LANE_ID(); asm volatile("" : "+v"(tl)); const int ln = tl & 63;
            LAS float* GR = (LAS float*)lds;
            LAS int* LC = (LAS int*)(lds + 32768);
            GAS int* ME = WSP(int, WS_ME); GAS float* MW = WSP(float, WS_MW); GAS int* WGCNT = WSP(int, WS_WGCNT); const GAS bf16_t* XBr = WSP(bf16_t, WS_XB);
            const GAS float* nffn1 = INF(I_NFFN) + (2 * j + 1) * D; const GAS float* rt = INF(I_MR) + (size_t)j * D * NE;
            for (int i = tl; i < D * NE; i += NWAVES * 64) { const int k = i >> 3, e = i & 7; GR[e * D + k] = nffn1[k] * rt[i]; }
            for (int ch = bx; ch < T / 128; ch += G) {
                if (tl < 16) LC[tl] = 0;
                __syncthreads();
                for (int q = 0; q < 16; ++q) {
                    const int tk = ch * 128 + wave * 16 + q;
                    const GAS u32x2* xr = (const GAS u32x2*)(XBr + (size_t)tk * D) + ln;
                    f32x4 v[4]; float s = 0.f, lg[8];
#pragma unroll
                    for (int qq = 0; qq < 4; ++qq) { const u32x2 w = xr[64 * qq]; v[qq][0] = __builtin_bit_cast(float, w.x << 16); v[qq][1] = __builtin_bit_cast(float, w.x & 0xffff0000u); v[qq][2] = __builtin_bit_cast(float, w.y << 16); v[qq][3] = __builtin_bit_cast(float, w.y & 0xffff0000u); s += dot4(v[qq]); }
#pragma unroll
                    for (int e = 0; e < 8; ++e) { float a = 0.f;
#pragma unroll
                        for (int qq = 0; qq < 4; ++qq) { const f32x4 g = *(const LAS f32x4*)(GR + e * D + 4 * ln + 256 * qq); a += (v[qq][0] * g[0] + v[qq][1] * g[1]) + (v[qq][2] * g[2] + v[qq][3] * g[3]); }
                        lg[e] = wave_sum(a); }
                    s = wave_sum(s);
                    const float rs = rsq(s * (1.0f / D) + EPS);
                    int e1 = 0; float l1 = lg[0];
#pragma unroll
                    for (int e = 1; e < 8; ++e) if (lg[e] > l1) { l1 = lg[e]; e1 = e; }
                    int e2 = 0; float l2 = -__builtin_inff();
#pragma unroll
                    for (int e = 0; e < 8; ++e) if (e != e1 && lg[e] > l2) { l2 = lg[e]; e2 = e; }
                    const float ex = __expf((l2 - l1) * rs), w1 = 1.0f / (1.0f + ex), w2 = ex / (1.0f + ex);
                    if (ln == 0) {
                        const int r1 = __hip_atomic_fetch_add(&LC[e1], 1, __ATOMIC_RELAXED, __HIP_MEMORY_SCOPE_WORKGROUP), r2 = __hip_atomic_fetch_add(&LC[8 + e2], 1, __ATOMIC_RELAXED, __HIP_MEMORY_SCOPE_WORKGROUP);
                        ME[tk] = e1 | (e2 << 4) | (r1 << 8) | (r2 << 16); MW[2 * tk] = w1; MW[2 * tk + 1] = w2;
                    }
                }
                __syncthreads();
                if (tl < 16) WGCNT[ch * 16 + tl] = LC[tl];
                __syncthreads();
            }
        }
        GRID_BAR();
        LAUNDER();
        if constexpr (PH(12))
        {
            int tl = wave * 64 + LANE_ID(); asm volatile("" : "+v"(tl));
            LAS int* PART = (LAS int*)lds;
            LAS int* BASE = (LAS int*)(lds + 4096);
            LAS int* OFFS = (LAS int*)(lds + 4096 + 64);
            GAS int* ME = WSP(int, WS_ME); GAS float* MW = WSP(float, WS_MW); GAS int* WGCNT = WSP(int, WS_WGCNT); GAS int* TOK = WSP(int, WS_TOK); GAS float* WSL = WSP(float, WS_WSL); GAS int* TAB = WSP(int, WS_TAB);
            { const int l = tl & 15, part = tl >> 4; int s = 0;
              for (int c = 0; c < 8; ++c) s += WGCNT[(part * 8 + c) * 16 + l];
              PART[part * 16 + l] = s; }
            __syncthreads();
            if (tl < 16) { int run = 0; for (int p = 0; p < 32; ++p) { const int v = PART[p * 16 + tl]; PART[p * 16 + tl] = run; run += v; } OFFS[tl] = run; }
            __syncthreads();
            if (tl == 0) { int tp = 0; for (int l = 0; l < 16; ++l) { BASE[l] = tp * 256; PFX[l] = tp; tp += (OFFS[l] + 255) >> 8; } PFX[16] = tp;
                if (bx == 0) { for (int l = 0; l <= 16; ++l) TAB[l] = PFX[l]; } }
            __syncthreads();
            if (bx < 16) { const int l = bx, tot = OFFS[l], b0 = BASE[l], e0 = b0 + (((tot + 255) >> 8) << 8);
                for (int s = b0 + tot + tl; s < e0; s += NWAVES * 64) { TOK[s] = -1; WSL[s] = 0.f; } }
            __syncthreads();
            for (int ch = bx; ch < T / 128; ch += G) {
                if (tl < 16) { int o = BASE[tl] + PART[(ch >> 3) * 16 + tl]; for (int c = (ch & ~7); c < ch; ++c) o += WGCNT[c * 16 + tl]; OFFS[tl] = o; }
                __syncthreads();
                if (tl < 128) { const int tk = ch * 128 + tl, me = ME[tk]; const int e1 = me & 15, e2 = (me >> 4) & 15, r1 = (me >> 8) & 255, r2 = (me >> 16) & 255;
                    const int s1 = OFFS[e1] + r1, s2 = OFFS[8 + e2] + r2;
                    TOK[s1] = tk; WSL[s1] = MW[2 * tk]; TOK[s2] = tk; WSL[s2] = MW[2 * tk + 1]; }
                __syncthreads();
            }
        }
        GRID_BAR();
        if (tid <= 16) PFX[tid] = WSP(int, WS_TAB)[tid];
        __syncthreads();
        LAUNDER();
        if constexpr (PH(13))
        {
            pg::SchedMoeGU S{WSP(bf16_t, WS_XB), WSP(int, WS_TOK), WTP(W_MGU), PFX, PFX[16], G, bxl};
            pg::EpiGU<true> E{WSP(float, WS_SSQ), ARP(AR_ACT), DFE, WSP(int, WS_TOK)};
            pg::gemm_phase(lds, D, S, E, wave);
        }
        GRID_BAR();
        LAUNDER();
        if constexpr (PH(14))
        {
            pg::SchedMoeDn S{ARP(AR_ACT), WTP(W_MDN), PFX, 0, PFX[8], G, bxl};
            pg::EpiMoeDn E{WSP(int, WS_TOK), WSP(float, WS_WSL), WSP(bf16_t, WS_XB), nullptr, nullptr, EX};
            pg::gemm_phase(lds, DFE, S, E, wave);
        }
        GRID_BAR();
        LAUNDER();
        if constexpr (PH(15))
        {
            pg::SchedMoeDn S{ARP(AR_ACT), WTP(W_MDN), PFX, PFX[8], PFX[16] - PFX[8], G, bxl};
            pg::EpiMoeDn E{WSP(int, WS_TOK), WSP(float, WS_WSL), WSP(bf16_t, WS_XB), j == 0 ? nullptr : out, j == 0 ? WSP(float, WS_SSQ) : nullptr, EX};
            pg::gemm_phase(lds, DFE, S, E, wave);
        }
        if (j == 0) GRID_BAR();
    }
#if PROBE
    GRID_BAR();
    {
        float da = 0.f, db = 0.f;
        for (int i = PROBE_A0; i < PROBE_A1; ++i) da += (float)(long long)(TS[i + 1] - TS[i]) * 0.01f;
        for (int i = PROBE_B0; i < PROBE_B1; ++i) db += (float)(long long)(TS[i + 1] - TS[i]) * 0.01f;
        const float delta = __builtin_sqrtf(da * 1e-6f * PROBE_SA);
        const int tl = wave * 64 + LANE_ID();
        for (size_t i = (size_t)bx * 512 + tl; i < (size_t)T * D / 4; i += (size_t)G * 512) { f32x4 v = ((GAS f32x4*)out)[i]; v = v * (1.0f + delta); ((GAS f32x4*)out)[i] = v; }
        __syncthreads();
        if (bx == 0 && tl == 0) out[0] += db * 0.02f;
    }
#endif
}

#undef tid
#undef lane
extern "C" void kernel_launch(void* const* d_in, const int* in_sizes, int n_in, void* d_out, int out_size, void* d_ws, size_t ws_size, hipStream_t stream) {
    static int grid = 0;
    if (grid == 0) {
        if (n_in != 22 || out_size != T * D || ws_size < WS_END) { fprintf(stderr, "kernel_launch: unexpected shapes (n_in %d, out %d, ws %zu)\n", n_in, out_size, ws_size); grid = -1; return; }
        int dev = 0, cus = 0;
        if (hipGetDevice(&dev) != hipSuccess || hipDeviceGetAttribute(&cus, hipDeviceAttributeMultiprocessorCount, dev) != hipSuccess) { grid = -1; return; }
        if (hipFuncSetAttribute((const void*)fwd, hipFuncAttributeMaxDynamicSharedMemorySize, LDS_BYTES) != hipSuccess) { fprintf(stderr, "kernel_launch: hipFuncSetAttribute failed\n"); grid = -1; return; }
        int per_cu = 0;
        if (hipOccupancyMaxActiveBlocksPerMultiprocessor(&per_cu, (const void*)fwd, NWAVES * 64, LDS_BYTES) != hipSuccess || per_cu < 1) fprintf(stderr, "kernel_launch: occupancy query says %d\n", per_cu);
        (void)hipGetLastError();
        grid = cus;
    }
    if (grid < 0) return;
    (void)hipMemsetAsync((char*)d_ws + WS_CTL, 0, CTL_ZERO_BYTES, stream);
    Args a{};
    for (int i = 0; i < 22; ++i) a.in[i] = d_in[i];
    a.out = (float*)d_out; a.ws = (unsigned char*)d_ws;
    hipLaunchKernelGGL(fwd, dim3(grid), dim3(NWAVES * 64), LDS_BYTES, stream, a);
}
```
